# Optimizing an MI355X kernel written in HIP

```python
import jax, jax.numpy as jnp
from jax import lax
import numpy as np

D_MODEL = 1024
BATCH = 4
SEQ = 4096
DEPTH = 4

N_MIXERS = 2
N_CONV_LAYERS = (DEPTH + N_MIXERS - 1) // N_MIXERS
N_RWKV_LAYERS = DEPTH // N_MIXERS
CONV_WIDTH = 3
RWKV_HEAD_DIM = 64
RWKV_HEADS = D_MODEL // RWKV_HEAD_DIM
DECAY_LORA = 64
ICLR_LORA = 64
GATE_LORA = 128
N_DIRECTIONS = 2
N_TOKEN_SHIFT_MIX = 6
GN_EPS = 64e-5
MEM_LEN = 256
XATTN_HEADS = 4
XATTN_HEAD_DIM = D_MODEL // XATTN_HEADS
N_EXPERTS = 16
CAPACITY_FACTOR = 2
EXPERT_D_FF = 1024
RMS_EPS = 1e-6

kernel_name = "hybrid_conv_rwkv7_ecmoe_encoder"


def rms_norm(x, g):
    xf = x.astype(jnp.float32)
    y = xf * lax.rsqrt(jnp.mean(xf * xf, axis=-1, keepdims=True) + RMS_EPS)
    return (y * g.astype(jnp.float32)).astype(x.dtype)


def short_conv_mixer(xn, w_in, conv_w, w_out):
    s = xn.shape[1]
    b_gate, c_gate, hx = jnp.split(xn @ w_in, 3, axis=-1)
    u = c_gate * hx
    up = jnp.pad(u, ((0, 0), (1, 1), (0, 0)))
    conv = up[:, :s] * conv_w[0] + up[:, 1:s + 1] * conv_w[1] + up[:, 2:] * conv_w[2]
    return (b_gate * conv) @ w_out


def wkv_scan(r, w, k, v, kk, a, reverse):
    b, s, h, n = r.shape
    seqs = tuple(jnp.moveaxis(t, 1, 0) for t in (r, w, k, v, kk, kk * a))

    def step(state, inp):
        r_t, w_t, k_t, v_t, kk_t, b_t = inp
        sa = jnp.einsum('bhvk,bhk->bhv', state, kk_t)
        state = (state * w_t[:, :, None, :]
                 - sa[..., None] * b_t[:, :, None, :]
                 + v_t[..., None] * k_t[:, :, None, :])
        y_t = jnp.einsum('bhvk,bhk->bhv', state, r_t)
        return state, y_t

    state0 = jnp.zeros((b, h, n, n), jnp.float32)
    _, ys = lax.scan(step, state0, seqs, reverse=reverse)
    return jnp.moveaxis(ys, 0, 1)


def rwkv7_bidirectional(xn, mu, w_rkv, w0, w1, w2, a0, a1, a2, g1, g2,
                        k_k, k_a, r_k, ln_w, ln_b, w_out):
    b, s, d = xn.shape
    h, n = RWKV_HEADS, RWKV_HEAD_DIM
    f32 = jnp.float32
    xp = jnp.pad(xn, ((0, 0), (1, 1), (0, 0)))
    xx = 0.5 * (xp[:, :s] + xp[:, 2:]) - xn
    x_rkv = xn[None] + xx[None] * mu[:3, None, None, :]
    rkv = jnp.einsum('nbsd,nde->nbse', x_rkv, w_rkv)
    r, k, v = rkv[0], rkv[1], rkv[2]
    xw = xn + xx * mu[3]
    xa = xn + xx * mu[4]
    xg = xn + xx * mu[5]
    w_raw = w0[:, None, None, :] + jnp.einsum(
        'nbsl,nld->nbsd', jnp.tanh(jnp.einsum('bsd,ndl->nbsl', xw, w1)), w2)
    log_w = -jax.nn.softplus(-w_raw.astype(f32)) - 0.5
    decay = jnp.exp(-jnp.exp(log_w))
    iclr = jax.nn.sigmoid((a0[:, None, None, :] + jnp.einsum(
        'nbsl,nld->nbsd', jnp.einsum('bsd,ndl->nbsl', xa, a1), a2)).astype(f32))
    gate = jax.nn.sigmoid(xg @ g1) @ g2
    kk = (k * k_k).astype(f32).reshape(b, s, h, n)
    kk = kk / jnp.maximum(jnp.linalg.norm(kk, axis=-1, keepdims=True), 1e-12)
    k_dir = k.astype(f32)[None] * (1.0 + (iclr - 1.0) * k_a.astype(f32))

    def heads(t):
        return t.reshape(t.shape[:-1] + (h, n))

    r_h, v_h = heads(r.astype(f32)), heads(v.astype(f32))
    k_h, w_h, a_h = heads(k_dir), heads(decay), heads(iclr)
    y = (wkv_scan(r_h, w_h[0], k_h[0], v_h, kk, a_h[0], False)
         + wkv_scan(r_h, w_h[1], k_h[1], v_h, kk, a_h[1], True))
    mean = jnp.mean(y, axis=-1, keepdims=True)
    var = jnp.mean(jnp.square(y - mean), axis=-1, keepdims=True)
    y = ((y - mean) * lax.rsqrt(var + GN_EPS)).reshape(b, s, d)
    y = y * ln_w.astype(f32) + ln_b.astype(f32)
    bonus = jnp.sum(r_h[None] * k_h * r_k.astype(f32), axis=(0, -1))[..., None] * v_h
    y = y + bonus.reshape(b, s, d)
    return (y.astype(xn.dtype) * gate) @ w_out


def memory_cross_attention(xn, memn, w_q, w_kv, w_o):
    b, s, d = xn.shape
    m = memn.shape[1]
    q = (xn @ w_q).reshape(b, s, XATTN_HEADS, XATTN_HEAD_DIM)
    kv = (memn @ w_kv).reshape(b, m, 2, XATTN_HEADS, XATTN_HEAD_DIM)
    k, v = kv[:, :, 0], kv[:, :, 1]
    scores = jnp.einsum('bshd,bmhd->bhsm', q, k).astype(jnp.float32) * XATTN_HEAD_DIM ** -0.5
    p = jax.nn.softmax(scores, axis=-1).astype(v.dtype)
    o = jnp.einsum('bhsm,bmhd->bshd', p, v).reshape(b, s, d)
    return o @ w_o


def expert_choice_moe(xn, router, w_gate, w_up, w_down):
    b, s, d = xn.shape
    cap = CAPACITY_FACTOR * s // N_EXPERTS
    probs = jax.nn.softmax((xn @ router).astype(jnp.float32), axis=-1)
    aff, idx = lax.top_k(jnp.swapaxes(probs, 1, 2), cap)
    bidx = jnp.arange(b)[:, None, None]
    xe = xn[bidx, idx]
    hid = jax.nn.silu(jnp.einsum('becd,edf->becf', xe, w_gate)) * jnp.einsum('becd,edf->becf', xe, w_up)
    ye = jnp.einsum('becf,efd->becd', hid, w_down) * aff[..., None].astype(xn.dtype)
    return jnp.zeros_like(xn).at[bidx, idx].add(ye)


def setup_inputs(seed: int = 0) -> dict:
    key = jax.random.key(seed)
    keys = iter(jax.random.split(key, 48))
    D, NC, NR, ND = D_MODEL, N_CONV_LAYERS, N_RWKV_LAYERS, N_DIRECTIONS
    E, F = N_EXPERTS, EXPERT_D_FF

    def nrm(shape, scale):
        return jax.random.normal(next(keys), shape, jnp.float32) * scale

    def gain(shape):
        return 1.0 + nrm(shape, 0.02)

    return {
        "x": nrm((BATCH, SEQ, D), 1.0),
        "mem": nrm((BATCH, MEM_LEN, D), 1.0),
        "norm_mix": gain((DEPTH, D)),
        "norm_xattn": gain((DEPTH, D)),
        "norm_mem": gain((DEPTH, D)),
        "norm_ffn": gain((DEPTH, D)),
        "norm_final": gain((D,)),
        "conv_w_in": nrm((NC, D, 3 * D), D ** -0.5),
        "conv_w": nrm((NC, CONV_WIDTH, D), 0.5),
        "conv_w_out": nrm((NC, D, D), D ** -0.5),
        "rwkv_mu": jax.random.uniform(next(keys), (NR, N_TOKEN_SHIFT_MIX, D), jnp.float32),
        "rwkv_w_rkv": nrm((NR, 3, D, D), D ** -0.5),
        "rwkv_w0": nrm((NR, ND, D), 1.0),
        "rwkv_w1": nrm((NR, ND, D, DECAY_LORA), D ** -0.5),
        "rwkv_w2": nrm((NR, ND, DECAY_LORA, D), 0.5 * DECAY_LORA ** -0.5),
        "rwkv_a0": nrm((NR, ND, D), 0.5),
        "rwkv_a1": nrm((NR, ND, D, ICLR_LORA), D ** -0.5),
        "rwkv_a2": nrm((NR, ND, ICLR_LORA, D), 0.5 * ICLR_LORA ** -0.5),
        "rwkv_g1": nrm((NR, D, GATE_LORA), D ** -0.5),
        "rwkv_g2": nrm((NR, GATE_LORA, D), GATE_LORA ** -0.5),
        "rwkv_k_k": 0.85 + nrm((NR, D), 0.05),
        "rwkv_k_a": 1.0 + nrm((NR, D), 0.05),
        "rwkv_r_k": nrm((NR, RWKV_HEADS, RWKV_HEAD_DIM), 0.1),
        "rwkv_ln_w": gain((NR, D)),
        "rwkv_ln_b": nrm((NR, D), 0.02),
        "rwkv_w_out": nrm((NR, D, D), D ** -0.5),
        "xattn_w_q": nrm((DEPTH, D, D), D ** -0.5),
        "xattn_w_kv": nrm((DEPTH, D, 2 * D), D ** -0.5),
        "xattn_w_o": nrm((DEPTH, D, D), D ** -0.5),
        "moe_router": nrm((DEPTH, D, E), D ** -0.5),
        "moe_w_gate": nrm((DEPTH, E, D, F), D ** -0.5),
        "moe_w_up": nrm((DEPTH, E, D, F), D ** -0.5),
        "moe_w_down": nrm((DEPTH, E, F, D), F ** -0.5),
    }


def reference(x, mem, norm_mix, norm_xattn, norm_mem, norm_ffn, norm_final,
              conv_w_in, conv_w, conv_w_out,
              rwkv_mu, rwkv_w_rkv, rwkv_w0, rwkv_w1, rwkv_w2, rwkv_a0, rwkv_a1, rwkv_a2,
              rwkv_g1, rwkv_g2, rwkv_k_k, rwkv_k_a, rwkv_r_k, rwkv_ln_w, rwkv_ln_b, rwkv_w_out,
              xattn_w_q, xattn_w_kv, xattn_w_o,
              moe_router, moe_w_gate, moe_w_up, moe_w_down):
    h = x
    for i in range(DEPTH):
        j = i // N_MIXERS
        xn = rms_norm(h, norm_mix[i])
        if i % N_MIXERS == 0:
            h = h + short_conv_mixer(xn, conv_w_in[j], conv_w[j], conv_w_out[j])
        else:
            h = h + rwkv7_bidirectional(
                xn, rwkv_mu[j], rwkv_w_rkv[j], rwkv_w0[j], rwkv_w1[j], rwkv_w2[j],
                rwkv_a0[j], rwkv_a1[j], rwkv_a2[j], rwkv_g1[j], rwkv_g2[j],
                rwkv_k_k[j], rwkv_k_a[j], rwkv_r_k[j], rwkv_ln_w[j], rwkv_ln_b[j], rwkv_w_out[j])
        h = h + memory_cross_attention(rms_norm(h, norm_xattn[i]), rms_norm(mem, norm_mem[i]),
                                       xattn_w_q[i], xattn_w_kv[i], xattn_w_o[i])
        h = h + expert_choice_moe(rms_norm(h, norm_ffn[i]), moe_router[i],
                                  moe_w_gate[i], moe_w_up[i], moe_w_down[i])
    return rms_norm(h, norm_final)
```

```cpp
#include <hip/hip_runtime.h>
#include <cstdio>
#include <cstdint>

#define LAS __attribute__((address_space(3)))
#define GAS __attribute__((address_space(1)))
typedef unsigned short bf16_t;
typedef short bf16x8 __attribute__((ext_vector_type(8)));
typedef float f32x4 __attribute__((ext_vector_type(4)));
typedef float f32x2 __attribute__((ext_vector_type(2)));
typedef unsigned u32x4 __attribute__((ext_vector_type(4)));
typedef unsigned u32x2 __attribute__((ext_vector_type(2)));

constexpr int NB = 4, SEQ = 4096, D = 1024, T = NB * SEQ, NL = 4;
constexpr int MEML = 256, XH = 4, XHD = 256;
constexpr int NE = 16, CAP = 512, NSLOT = NB * NE * CAP;
constexpr int RH = 16, RN = 64;
constexpr float RMS_EPS = 1e-6f, GN_EPS = 64e-5f;

constexpr size_t MiB = 1u << 20;
constexpr size_t WS_CTL = 0, CTL_ZERO_BYTES = 64 * 1024;
constexpr size_t WS_W = 1 * MiB;
constexpr size_t SZ_CONVIN = (size_t)3072 * 1024 * 2, SZ_SQ = (size_t)1024 * 1024 * 2, SZ_L1 = (size_t)768 * 1024 * 2, SZ_L2 = (size_t)5 * 1024 * 128 * 2;
constexpr size_t WS_CONVIN = WS_W;
constexpr size_t WS_CONVOUT = WS_CONVIN + 2 * SZ_CONVIN;
constexpr size_t WS_RKV = WS_CONVOUT + 2 * SZ_SQ;
constexpr size_t WS_L1 = WS_RKV + 6 * SZ_SQ;
constexpr size_t WS_L2 = WS_L1 + 2 * SZ_L1;
constexpr size_t WS_ROUT = WS_L2 + 2 * SZ_L2;
constexpr size_t WS_WQ = WS_ROUT + 2 * SZ_SQ;
constexpr size_t WS_WKV = WS_WQ + 4 * SZ_SQ;
constexpr size_t WS_WO = WS_WKV + 8 * SZ_SQ;
constexpr size_t WS_WGU = WS_WO + 4 * SZ_SQ;
constexpr size_t WS_WD = WS_WGU + 64 * MiB;
constexpr size_t WS_HA = WS_WD + 32 * MiB;
constexpr size_t WS_HB = WS_HA + 64 * MiB;
constexpr size_t WS_XN = WS_HB + 64 * MiB;
constexpr size_t WS_MEMN = WS_XN + 32 * MiB;
constexpr size_t WS_KM = WS_MEMN + 8 * MiB;
constexpr size_t WS_VT = WS_KM + 8 * MiB;
constexpr size_t WS_PROBS = WS_VT + 8 * MiB;
constexpr size_t WS_SLOT = WS_PROBS + 1 * MiB;
constexpr size_t WS_AFF = WS_SLOT + 1 * MiB;
constexpr size_t WS_GIDX = WS_AFF + 512 * 1024;
constexpr size_t WS_POOL = WS_AFF + 1 * MiB;
constexpr size_t PO_U = 0, PO_BG = 32 * MiB, PO_G = 64 * MiB;
constexpr size_t PO_Q = 0, PO_P = 32 * MiB, PO_O = 64 * MiB;
constexpr size_t PO_XE = 0, PO_HID = 64 * MiB, PO_YE = 192 * MiB;
constexpr size_t PO_X6 = 0;
constexpr size_t PO_CP = 0, PO_CQ = 64 * MiB, PO_CG = 128 * MiB;
constexpr size_t PO_Z = 0;
constexpr size_t PO_RKV = 192 * MiB;
constexpr size_t PO_LORA = 288 * MiB;
constexpr size_t PO_LOGW = 300 * MiB;
constexpr size_t PO_ICLR = 428 * MiB;
constexpr size_t PO_GATE = 492 * MiB;
constexpr size_t PO_Y = 524 * MiB;
constexpr size_t PO_WQK = 588 * MiB;
constexpr size_t PO_VOT = 620 * MiB;
constexpr size_t PO_BONUS = 652 * MiB;
constexpr size_t WS_END = WS_POOL + 654 * MiB;
static_assert(WS_END <= 1024 * MiB, "workspace map exceeds 1 GiB");

constexpr int CW_TMO = 0, CW_BAR = 4096;

constexpr int NWAVES = 8, NTHREADS = 512;
constexpr int RING_BYTES = 131072, LDS_BYTES = 163840, LDSCTL_OFF = LDS_BYTES - 1024, MISC_OFF = LDSCTL_OFF + 320;

typedef __bf16 hwbf16x2 __attribute__((ext_vector_type(2)));
__device__ __forceinline__ unsigned pk2(float lo, float hi) { const f32x2 v = {lo, hi}; const hwbf16x2 b = __builtin_convertvector(v, hwbf16x2); return __builtin_bit_cast(unsigned, b); }
__device__ __forceinline__ unsigned f2bf(float f) { return pk2(f, 0.f) & 0xffffu; }
typedef int i32x8 __attribute__((ext_vector_type(8)));
typedef int i32x4 __attribute__((ext_vector_type(4)));
__device__ __forceinline__ unsigned pk_fp8x4(float a, float b, float c, float d) {
    a = __builtin_amdgcn_fmed3f(a, -448.f, 448.f); b = __builtin_amdgcn_fmed3f(b, -448.f, 448.f); c = __builtin_amdgcn_fmed3f(c, -448.f, 448.f); d = __builtin_amdgcn_fmed3f(d, -448.f, 448.f);
    unsigned p = (unsigned)__builtin_amdgcn_cvt_pk_fp8_f32(a, b, 0, false); return (unsigned)__builtin_amdgcn_cvt_pk_fp8_f32(c, d, (int)p, true); }
constexpr float FP8_SX = 32.f, FP8_SW = 512.f, FP8_SH = 16.f;
__device__ __forceinline__ float bf_lo(unsigned w) { return __builtin_bit_cast(float, w << 16); }
__device__ __forceinline__ float bf_hi(unsigned w) { return __builtin_bit_cast(float, w & 0xffff0000u); }
__device__ __forceinline__ float wave_sum(float v) {
#pragma unroll
    for (int o = 1; o < 64; o <<= 1) v += __shfl_xor(v, o);
    return v;
}
__device__ __forceinline__ float sigmoidf_(float x) { return __builtin_amdgcn_rcpf(1.f + __expf(-x)); }

__device__ __forceinline__ int rs16_index(int lane) { return ((lane >> 5) & 1) * 8 + ((lane >> 4) & 1) * 4 + ((lane >> 3) & 1) * 2 + ((lane >> 2) & 1); }
__device__ __forceinline__ float reduce_scatter16(const float (&v)[16], int lane) {
    float a[8], b[4], c[2], d;
    { const bool hi = (lane & 32) != 0;
#pragma unroll
      for (int i = 0; i < 8; ++i) { const float keep = hi ? v[8 + i] : v[i], send = hi ? v[i] : v[8 + i]; a[i] = keep + __shfl_xor(send, 32); } }
    { const bool hi = (lane & 16) != 0;
#pragma unroll
      for (int i = 0; i < 4; ++i) { const float keep = hi ? a[4 + i] : a[i], send = hi ? a[i] : a[4 + i]; b[i] = keep + __shfl_xor(send, 16); } }
    { const bool hi = (lane & 8) != 0;
#pragma unroll
      for (int i = 0; i < 2; ++i) { const float keep = hi ? b[2 + i] : b[i], send = hi ? b[i] : b[2 + i]; c[i] = keep + __shfl_xor(send, 8); } }
    { const bool hi = (lane & 4) != 0; const float keep = hi ? c[1] : c[0], send = hi ? c[0] : c[1]; d = keep + __shfl_xor(send, 4); }
    d += __shfl_xor(d, 2); d += __shfl_xor(d, 1);
    return d;
}
#define LDS_WAIT() asm volatile("s_waitcnt lgkmcnt(0)" ::: "memory")
#define LDS_BARRIER() do { asm volatile("s_waitcnt lgkmcnt(0)" ::: "memory"); __builtin_amdgcn_s_barrier(); asm volatile("" ::: "memory"); } while (0)
#define VM_WAIT() asm volatile("s_waitcnt vmcnt(0)" ::: "memory")

namespace pg8 {
constexpr int BM = 256, BK = 64, HALF = 128, HTB = HALF * BK * 2, STAGE_BYTES = 8 * HTB, NXCD = 8, WGM = 8;
__host__ __device__ __forceinline__ int lds_byte(int r, int c) { const int st = (r >> 4) * 2 + (c >> 5), rr = r & 15, cc = c & 31, ob = rr * 64 + cc * 2; return st * 1024 + (ob ^ (((ob >> 9) & 1) << 5)); }
__host__ __device__ __forceinline__ void stage_rc(int b, int& R, int& C) { const int st = b / 1024, sb = b % 1024, swz = sb ^ (((sb >> 9) & 1) << 5); R = (st >> 1) * 16 + swz / 64; C = (st & 1) * 32 + (swz % 64) / 2; }
__host__ __device__ __forceinline__ int perm32(int rho) { const int n = rho >> 4, i = rho & 15; return 8 * (i >> 2) + 4 * n + (i & 3); }

struct Unit { const char* a; const char* b; int pm, pn, sub; };

__device__ __forceinline__ unsigned cvt_pk_bf16(float lo, float hi) { return pk2(lo, hi); }

template <int LDA, int LDB, int KDIM, class Epi, class Sched, bool ALIGN_EPI = false, bool SP2 = true, bool GATHER = false, bool FP8 = false>
__device__ __forceinline__ void gemm_phase(LAS unsigned char* lds, const Sched& S, const Epi& E, const int* gidx = nullptr) {
    const int tid = threadIdx.x, wid = __builtin_amdgcn_readfirstlane(tid >> 6), lane = tid & 63, wr = wid >> 2, wc = wid & 3, fr = lane & 15, fq = lane >> 4;
    constexpr int nt = KDIM / BK;
    unsigned voffA[2], voffB[2];
    unsigned gA0[2], gA1[2], nA0[2], nA1[2]; int stR[2], stC[2];
#pragma unroll
    for (int i = 0; i < 2; ++i) { int R, C; stage_rc(tid * 16 + i * 8192, R, C); const int Rb = Epi::PERM ? ((R & ~31) + perm32(R & 31)) : R;
        voffA[i] = (unsigned)(R * LDA + C) * 2u; voffB[i] = (unsigned)(Rb * LDB + C) * 2u; if constexpr (GATHER) { stR[i] = R; stC[i] = C; } }
#define PG8_GATHER_OFFS(o0, o1, pm_) do { _Pragma("unroll") for (int i_ = 0; i_ < 2; ++i_) { \
        o0[i_] = (unsigned)(gidx[(pm_) * BM + stR[i_]] * LDA + stC[i_]) * 2u; o1[i_] = (unsigned)(gidx[(pm_) * BM + HALF + stR[i_]] * LDA + stC[i_]) * 2u; } } while (0)
#define PG8_STAGE_A(bufoff, base, h, nextunit) do { if constexpr (GATHER) { if (nextunit) { if ((h) == 0) PG8_STAGE(bufoff, base, nA0); else PG8_STAGE(bufoff, base, nA1); } else { if ((h) == 0) PG8_STAGE(bufoff, base, gA0); else PG8_STAGE(bufoff, base, gA1); } } \
        else PG8_STAGE(bufoff, (base) + (h) * hstepA, voffA); } while (0)
    constexpr size_t kstep = (size_t)(BK * 2);
    constexpr size_t hstepA = (size_t)HALF * LDA * 2, hstepB = (size_t)HALF * LDB * 2;
    const unsigned ldsw = (unsigned)wid * 1024u;
    const int aoff = FP8 ? lds_byte(wr * 64 + fr, fq * 16) + (fq & 1) * 16 : lds_byte(wr * 64 + fr, fq * 8), boff = FP8 ? lds_byte(wc * 32 + fr, fq * 16) + (fq & 1) * 16 : lds_byte(wc * 32 + fr, fq * 8);
    const int kst = FP8 ? 16 - (fq & 1) * 32 : 1024;
    int sc1 = 0x7f7f7f7f; if constexpr (FP8) asm volatile("" : "+v"(sc1));
#define PG8_SA(b, h) (((b) * 2 + (h)) * HTB)
#define PG8_SB(b, h) ((4 + (b) * 2 + (h)) * HTB)
#define PG8_STAGE(bufoff, gbase, voff) do { _Pragma("unroll") for (int _i = 0; _i < 2; ++_i) \
        __builtin_amdgcn_global_load_lds((const unsigned*)((const char*)(gbase) + (voff)[_i]), (LAS unsigned*)(lds + (bufoff) + ldsw + _i * 8192), 16, 0, 0); } while (0)
#define PG8_LDA(dst, b, h) do { _Pragma("unroll") for (int m = 0; m < 4; ++m) _Pragma("unroll") for (int k = 0; k < 2; ++k) dst[m][k] = *(const LAS bf16x8*)(lds + PG8_SA(b, h) + aoff + m * 2048 + k * kst); } while (0)
#define PG8_LDB(dst, b, h) do { _Pragma("unroll") for (int n = 0; n < 2; ++n) _Pragma("unroll") for (int k = 0; k < 2; ++k) dst[n][k] = *(const LAS bf16x8*)(lds + PG8_SB(b, h) + boff + n * 2048 + k * kst); } while (0)
#define PG8_MMA(ai, bj, At, Bt) do { __builtin_amdgcn_s_setprio(1); _Pragma("unroll") for (int m = 0; m < 4; ++m) _Pragma("unroll") for (int n = 0; n < 2; ++n) { \
        if constexpr (FP8) { const i32x8 a8 = __builtin_shufflevector(__builtin_bit_cast(i32x4, At[m][0]), __builtin_bit_cast(i32x4, At[m][1]), 0, 1, 2, 3, 4, 5, 6, 7), b8 = __builtin_shufflevector(__builtin_bit_cast(i32x4, Bt[n][0]), __builtin_bit_cast(i32x4, Bt[n][1]), 0, 1, 2, 3, 4, 5, 6, 7); \
            asm volatile("v_mfma_scale_f32_16x16x128_f8f6f4 %0, %1, %2, %0, %3, %3 op_sel_hi:[0,0,0]" : "+v"(acc[ai][bj][m][n]) : "v"(b8), "v"(a8), "v"(sc1)); } \
        else { _Pragma("unroll") for (int k = 0; k < 2; ++k) acc[ai][bj][m][n] = __builtin_amdgcn_mfma_f32_16x16x32_bf16(Bt[n][k], At[m][k], acc[ai][bj][m][n], 0, 0, 0); } } __builtin_amdgcn_s_setprio(0); } while (0)
#define PG8_WAIT_V(n) asm volatile("s_waitcnt vmcnt(" #n ")" ::: "memory")
#define PG8_WAIT_L(n) asm volatile("s_waitcnt lgkmcnt(" #n ")" ::: "memory")
#define PG8_BAR __builtin_amdgcn_s_barrier()
#define PG8_SCHED __builtin_amdgcn_sched_barrier(0)
    Unit cur, nxt; int ui = 0;
    if (!S.next(0, cur)) return;
    f32x4 acc[2][2][4][2];
#pragma unroll
    for (int a = 0; a < 2; ++a)
#pragma unroll
        for (int b = 0; b < 2; ++b)
#pragma unroll
            for (int m = 0; m < 4; ++m)
#pragma unroll
                for (int n = 0; n < 2; ++n) acc[a][b][m][n] = (f32x4){0.f, 0.f, 0.f, 0.f};
    bf16x8 At[4][2], B0[2][2], B1[2][2];
    const char* cA = cur.a; const char* cB = cur.b;
    if constexpr (GATHER) PG8_GATHER_OFFS(gA0, gA1, cur.pm);
    static_assert(SP2, "only the SP2 K-loop is kept");
    PG8_STAGE(PG8_SB(0, 0), cB, voffB); PG8_STAGE(PG8_SB(0, 1), cB + hstepB, voffB); PG8_STAGE_A(PG8_SA(0, 0), cA, 0, false); PG8_STAGE_A(PG8_SA(0, 1), cA, 1, false);
    if (wr == 1) PG8_BAR;
    PG8_WAIT_V(2); PG8_BAR;
    PG8_STAGE(PG8_SB(1, 0), cB + kstep, voffB); PG8_STAGE_A(PG8_SA(1, 0), cA + kstep, 0, false); PG8_STAGE(PG8_SB(1, 1), cB + hstepB + kstep, voffB);
    PG8_WAIT_V(6); PG8_BAR;
    for (;;) {
        const bool has_next = S.next(ui + 1, nxt);
        const char* nA = has_next ? nxt.a : cA; const char* nB = has_next ? nxt.b : cB;
        if constexpr (GATHER) { if (has_next) PG8_GATHER_OFFS(nA0, nA1, nxt.pm); else { nA0[0] = gA0[0]; nA0[1] = gA0[1]; nA1[0] = gA1[0]; nA1[1] = gA1[1]; } }
        int ntv = nt; if constexpr (FP8) asm volatile("" : "+s"(ntv));
#pragma unroll 1
        for (int t = 0; t < ntv; t += 2) {
            const bool last = (t == ntv - 2);
            const char* a1 = cA + (size_t)(t + 1) * kstep;
            const char* a2 = last ? nA : cA + (size_t)(t + 2) * kstep; const char* b2 = last ? nB : cB + (size_t)(t + 2) * kstep;
            const char* a3 = a2 + kstep; const char* b3 = b2 + kstep;
            PG8_LDB(B0, 0, 0); PG8_LDB(B1, 0, 1); PG8_SCHED; PG8_LDA(At, 0, 0); PG8_STAGE_A(PG8_SA(1, 1), a1, 1, false);
            PG8_WAIT_V(8); PG8_WAIT_L(0); PG8_BAR; PG8_MMA(0, 0, At, B0); PG8_MMA(0, 1, At, B1); PG8_BAR; PG8_SCHED;
            PG8_LDA(At, 0, 1); PG8_STAGE(PG8_SB(0, 0), b2, voffB); PG8_STAGE(PG8_SB(0, 1), b2 + hstepB, voffB); PG8_STAGE_A(PG8_SA(0, 0), a2, 0, last);
            PG8_WAIT_V(8); PG8_WAIT_L(0); PG8_BAR; PG8_MMA(1, 0, At, B0); PG8_MMA(1, 1, At, B1); PG8_BAR; PG8_SCHED;
            PG8_LDB(B0, 1, 0); PG8_LDB(B1, 1, 1); PG8_SCHED; PG8_LDA(At, 1, 0); PG8_STAGE_A(PG8_SA(0, 1), a2, 1, last);
            PG8_WAIT_V(8); PG8_WAIT_L(0); PG8_BAR; PG8_MMA(0, 0, At, B0); PG8_MMA(0, 1, At, B1); PG8_BAR; PG8_SCHED;
            PG8_LDA(At, 1, 1); PG8_STAGE(PG8_SB(1, 0), b3, voffB); PG8_STAGE(PG8_SB(1, 1), b3 + hstepB, voffB); PG8_STAGE_A(PG8_SA(1, 0), a3, 0, last);
            PG8_WAIT_V(8); PG8_WAIT_L(0); PG8_BAR; PG8_MMA(1, 0, At, B0); PG8_MMA(1, 1, At, B1); PG8_BAR; PG8_SCHED;
        }
        if constexpr (FP8) {
#pragma unroll
            for (int a_ = 0; a_ < 2; ++a_)
#pragma unroll
                for (int b_ = 0; b_ < 2; ++b_)
                    asm volatile("s_nop 15\n\ts_nop 3" : "+v"(acc[a_][b_][0][0]), "+v"(acc[a_][b_][0][1]), "+v"(acc[a_][b_][1][0]), "+v"(acc[a_][b_][1][1]), "+v"(acc[a_][b_][2][0]), "+v"(acc[a_][b_][2][1]), "+v"(acc[a_][b_][3][0]), "+v"(acc[a_][b_][3][1])); }
        if constexpr (ALIGN_EPI) { if (wr == 0) PG8_BAR; }
        if constexpr (!Epi::AFTER_DRAIN) { E(acc, cur, wr, wc, fr, fq); }
        if (!has_next) break;
#pragma unroll
        for (int a = 0; a < 2; ++a)
#pragma unroll
            for (int b = 0; b < 2; ++b)
#pragma unroll
                for (int m = 0; m < 4; ++m)
#pragma unroll
                    for (int n = 0; n < 2; ++n) acc[a][b][m][n] = (f32x4){0.f, 0.f, 0.f, 0.f};
        cur = nxt; cA = nA; cB = nB; ++ui;
        if constexpr (GATHER) { gA0[0] = nA0[0]; gA0[1] = nA0[1]; gA1[0] = nA1[0]; gA1[1] = nA1[1]; }
        if constexpr (ALIGN_EPI) { if (wr == 1) PG8_BAR; }
    }
    PG8_WAIT_V(0);
    if constexpr (!ALIGN_EPI) { if (wr == 0) PG8_BAR; }
    PG8_BAR;
    if constexpr (Epi::AFTER_DRAIN) { E.fused(acc, cur, wr, wc, fr, fq, lds, wid, lane); }
#undef PG8_GATHER_OFFS
#undef PG8_STAGE_A
#undef PG8_SA
#undef PG8_SB
#undef PG8_STAGE
#undef PG8_LDA
#undef PG8_LDB
#undef PG8_MMA
#undef PG8_WAIT_V
#undef PG8_WAIT_L
#undef PG8_BAR
#undef PG8_SCHED
}

template <int NM, int NN, int NSUB, int PMDIV, int AMOD, size_t SA, size_t SB, size_t SBE, size_t TA, size_t TB>
struct GroupSched {
    const char* A0; const char* B0; int G, c;
    __device__ __forceinline__ bool next(int i, Unit& u) const {
        constexpr int per = NM * NN, nwg = NSUB * per; const int L = i * G + c; if (L >= nwg) return false;
        int wgid = L; { constexpr int q = nwg / NXCD, r = nwg % NXCD; const int xcd = wgid % NXCD, off = wgid / NXCD; wgid = (xcd < r ? xcd * (q + 1) : r * (q + 1) + (xcd - r) * q) + off; }
        const int sub = wgid / per, w = wgid - sub * per;
        constexpr int nig = WGM * NN; const int gid = w / nig, fm = gid * WGM, gsz = (NM - fm) < WGM ? (NM - fm) : WGM;
        u.pm = fm + ((w % nig) % gsz); u.pn = (w % nig) / gsz; u.sub = sub;
        int asub = sub; if constexpr (AMOD != 0) asub = sub % AMOD;
        int pe = 0; if constexpr (PMDIV != 0) pe = u.pm / PMDIV;
        u.a = A0 + (size_t)asub * SA + (size_t)u.pm * TA; u.b = B0 + (size_t)sub * SB + (size_t)pe * SBE + (size_t)u.pn * TB; return true;
    }
};
template <size_t TA, size_t TB>
struct OneUnitSched {
    const char* A0; const char* B0; int pm, pn;
    __device__ __forceinline__ bool next(int i, Unit& u) const { if (i > 0) return false; u.pm = pm; u.pn = pn; u.sub = 0; u.a = A0 + (size_t)pm * TA; u.b = B0 + (size_t)pn * TB; return true; }
};
template <size_t SBB, size_t SBH>
struct AttnSched {
    const char* A0; const char* B0; int G, c, only;
    __device__ __forceinline__ bool next(int i, Unit& u) const {
        int L; if (only >= 0) { if (i > 0) return false; L = only; } else { L = i * G + c; if (L >= 256) return false; }
        const int pm = L >> 2, h = L & 3, b = pm >> 4;
        u.pm = pm; u.pn = h; u.sub = 0;
        u.a = A0 + (size_t)pm * (256 * 1024 * 2) + (size_t)h * 512; u.b = B0 + (size_t)b * SBB + (size_t)h * SBH; return true;
    }
};

#define EPI_ROWLOOP for (int ai = 0; ai < 2; ++ai) _Pragma("unroll") for (int m = 0; m < 4; ++m)
typedef const f32x4 (&AccT)[2][2][4][2];

struct EpiBf16 {
    static constexpr bool PERM = true, AFTER_DRAIN = false;
    bf16_t* O; int ldc; size_t sub_stride; float scale;
    __device__ __forceinline__ void operator()(AccT acc, const Unit& u, int wr, int wc, int fr, int fq) const {
        bf16_t* base = O + (size_t)u.sub * sub_stride; const int row0 = u.pm * BM + wr * 64 + fr, col0 = u.pn * BM + wc * 32 + 8 * fq;
#pragma unroll
        EPI_ROWLOOP { bf16_t* rowp = base + (size_t)(row0 + ai * HALF + m * 16) * ldc + col0;
#pragma unroll
            for (int bj = 0; bj < 2; ++bj) { const f32x4 v0 = acc[ai][bj][m][0] * scale, v1 = acc[ai][bj][m][1] * scale; u32x4 w;
                w.x = cvt_pk_bf16(v0[0], v0[1]); w.y = cvt_pk_bf16(v0[2], v0[3]); w.z = cvt_pk_bf16(v1[0], v1[1]); w.w = cvt_pk_bf16(v1[2], v1[3]); *(u32x4*)(rowp + bj * HALF) = w; } }
    }
};
struct EpiBf16R {
    static constexpr bool PERM = true, AFTER_DRAIN = false;
    bf16_t* O; int ldc; float scale; const LAS float* rs;
    __device__ __forceinline__ void operator()(AccT acc, const Unit& u, int wr, int wc, int fr, int fq) const {
        const int lr0 = wr * 64 + fr, row0 = u.pm * BM + lr0, col0 = u.pn * BM + wc * 32 + 8 * fq;
#pragma unroll
        EPI_ROWLOOP { bf16_t* rowp = O + (size_t)(row0 + ai * HALF + m * 16) * ldc + col0; const float sc = scale * rs[lr0 + ai * HALF + m * 16];
#pragma unroll
            for (int bj = 0; bj < 2; ++bj) { const f32x4 v0 = acc[ai][bj][m][0] * sc, v1 = acc[ai][bj][m][1] * sc; u32x4 w;
                w.x = cvt_pk_bf16(v0[0], v0[1]); w.y = cvt_pk_bf16(v0[2], v0[3]); w.z = cvt_pk_bf16(v1[0], v1[1]); w.w = cvt_pk_bf16(v1[2], v1[3]); *(u32x4*)(rowp + bj * HALF) = w; } }
    }
};
struct EpiConvIn {
    static constexpr bool PERM = true, AFTER_DRAIN = false;
    bf16_t* U; bf16_t* BG;
    __device__ __forceinline__ void operator()(AccT acc, const Unit& u, int wr, int wc, int fr, int fq) const {
        const int row0 = u.pm * BM + wr * 64 + fr, cw = wc * 32 + 8 * fq;
        if (u.pn < 8) {
#pragma unroll
            EPI_ROWLOOP { bf16_t* rowp = U + (size_t)(row0 + ai * HALF + m * 16) * D + u.pn * 128 + cw; const f32x4 v0 = acc[ai][0][m][0] * acc[ai][1][m][0], v1 = acc[ai][0][m][1] * acc[ai][1][m][1]; u32x4 w;
                w.x = cvt_pk_bf16(v0[0], v0[1]); w.y = cvt_pk_bf16(v0[2], v0[3]); w.z = cvt_pk_bf16(v1[0], v1[1]); w.w = cvt_pk_bf16(v1[2], v1[3]); *(u32x4*)rowp = w; }
        } else {
#pragma unroll
            EPI_ROWLOOP { bf16_t* rowp = BG + (size_t)(row0 + ai * HALF + m * 16) * D + (u.pn - 8) * 256 + cw;
#pragma unroll
                for (int bj = 0; bj < 2; ++bj) { const f32x4 v0 = acc[ai][bj][m][0], v1 = acc[ai][bj][m][1]; u32x4 w;
                    w.x = cvt_pk_bf16(v0[0], v0[1]); w.y = cvt_pk_bf16(v0[2], v0[3]); w.z = cvt_pk_bf16(v1[0], v1[1]); w.w = cvt_pk_bf16(v1[2], v1[3]); *(u32x4*)(rowp + bj * HALF) = w; } }
        }
    }
};
struct EpiSwiGLU {
    static constexpr bool PERM = true, AFTER_DRAIN = false;
    bf16_t* H;
    __device__ __forceinline__ void operator()(AccT acc, const Unit& u, int wr, int wc, int fr, int fq) const {
        const int row0 = u.pm * BM + wr * 64 + fr, cw = u.pn * 128 + wc * 32 + 8 * fq;
#pragma unroll
        EPI_ROWLOOP { bf16_t* rowp = H + (size_t)(row0 + ai * HALF + m * 16) * 1024 + cw; float o[8];
#pragma unroll
            for (int n = 0; n < 2; ++n)
#pragma unroll
                for (int j = 0; j < 4; ++j) { const float g = acc[ai][0][m][n][j], up = acc[ai][1][m][n][j]; o[n * 4 + j] = g * sigmoidf_(g) * up; }
            u32x4 w; w.x = cvt_pk_bf16(o[0], o[1]); w.y = cvt_pk_bf16(o[2], o[3]); w.z = cvt_pk_bf16(o[4], o[5]); w.w = cvt_pk_bf16(o[6], o[7]); *(u32x4*)rowp = w; }
    }
};
struct EpiSwiGLU8 {
    static constexpr bool PERM = true, AFTER_DRAIN = false;
    unsigned char* H;
    __device__ __forceinline__ void operator()(AccT acc, const Unit& u, int wr, int wc, int fr, int fq) const {
        const int row0 = u.pm * BM + wr * 64 + fr, cw = u.pn * 128 + wc * 32 + 8 * fq; constexpr float inv = 1.f / (FP8_SX * FP8_SW);
#pragma unroll
        EPI_ROWLOOP { unsigned char* rowp = H + (size_t)(row0 + ai * HALF + m * 16) * 1024 + cw; float o[8];
#pragma unroll
            for (int n = 0; n < 2; ++n)
#pragma unroll
                for (int j = 0; j < 4; ++j) { const float g = acc[ai][0][m][n][j] * inv, up = acc[ai][1][m][n][j] * (inv * FP8_SH); o[n * 4 + j] = g * sigmoidf_(g) * up; }
            u32x2 w; w.x = pk_fp8x4(o[0], o[1], o[2], o[3]); w.y = pk_fp8x4(o[4], o[5], o[6], o[7]); *(u32x2*)rowp = w; }
    }
};
struct EpiDown {
    static constexpr bool PERM = true, AFTER_DRAIN = false;
    bf16_t* Y; const float* aff; float post;
    __device__ __forceinline__ void operator()(AccT acc, const Unit& u, int wr, int wc, int fr, int fq) const {
        const int row0 = u.pm * BM + wr * 64 + fr, col0 = u.pn * BM + wc * 32 + 8 * fq;
#pragma unroll
        EPI_ROWLOOP { const int row = row0 + ai * HALF + m * 16; const float s = aff[row] * post; bf16_t* rowp = Y + (size_t)row * 1024 + col0;
#pragma unroll
            for (int bj = 0; bj < 2; ++bj) { const f32x4 v0 = acc[ai][bj][m][0] * s, v1 = acc[ai][bj][m][1] * s; u32x4 w;
                w.x = cvt_pk_bf16(v0[0], v0[1]); w.y = cvt_pk_bf16(v0[2], v0[3]); w.z = cvt_pk_bf16(v1[0], v1[1]); w.w = cvt_pk_bf16(v1[2], v1[3]); *(u32x4*)(rowp + bj * HALF) = w; } }
    }
};
template <bool BASEF32, bool SSQ = false>
struct EpiResidualT {
    static constexpr bool PERM = true, AFTER_DRAIN = false;
    const void* base; bf16_t* out; float* ssq;
    __device__ __forceinline__ void operator()(AccT acc, const Unit& u, int wr, int wc, int fr, int fq) const {
        const int row0 = u.pm * BM + wr * 64 + fr, col0 = u.pn * BM + wc * 32 + 8 * fq;
#pragma unroll
        EPI_ROWLOOP { const int row = row0 + ai * HALF + m * 16; const size_t off = (size_t)row * D + col0; float sq = 0.f;
#pragma unroll
            for (int bj = 0; bj < 2; ++bj) { f32x4 v0 = acc[ai][bj][m][0], v1 = acc[ai][bj][m][1];
                if constexpr (BASEF32) { const float* bp = (const float*)base + off + bj * HALF; v0 += *(const f32x4*)bp; v1 += *(const f32x4*)(bp + 4); }
                else { const u32x4 b = *(const u32x4*)((const bf16_t*)base + off + bj * HALF); v0[0] += bf_lo(b.x); v0[1] += bf_hi(b.x); v0[2] += bf_lo(b.y); v0[3] += bf_hi(b.y); v1[0] += bf_lo(b.z); v1[1] += bf_hi(b.z); v1[2] += bf_lo(b.w); v1[3] += bf_hi(b.w); }
                if constexpr (SSQ) sq += ((v0[0] * v0[0] + v0[1] * v0[1]) + (v0[2] * v0[2] + v0[3] * v0[3])) + ((v1[0] * v1[0] + v1[1] * v1[1]) + (v1[2] * v1[2] + v1[3] * v1[3]));
                u32x4 w; w.x = cvt_pk_bf16(v0[0], v0[1]); w.y = cvt_pk_bf16(v0[2], v0[3]); w.z = cvt_pk_bf16(v1[0], v1[1]); w.w = cvt_pk_bf16(v1[2], v1[3]); *(u32x4*)(out + off + bj * HALF) = w; }
            if constexpr (SSQ) { sq += __shfl_xor(sq, 16); sq += __shfl_xor(sq, 32); if (fq == 0) ssq[(size_t)row * 16 + u.pn * 4 + wc] = sq; } }
    }
};
typedef EpiResidualT<false> EpiResidual;
struct EpiF32 {
    static constexpr bool PERM = false, AFTER_DRAIN = false;
    float* out; size_t sub_stride;
    __device__ __forceinline__ void operator()(AccT acc, const Unit& u, int wr, int wc, int fr, int fq) const {
        float* o = out + (size_t)u.sub * sub_stride; const int row0 = u.pm * BM + wr * 64 + fr, col0 = u.pn * BM + wc * 32 + 4 * fq;
#pragma unroll
        EPI_ROWLOOP { const size_t off = (size_t)(row0 + ai * HALF + m * 16) * D + col0;
#pragma unroll
            for (int bj = 0; bj < 2; ++bj)
#pragma unroll
                for (int n = 0; n < 2; ++n) *(f32x4*)(o + off + bj * HALF + n * 16) = acc[ai][bj][m][n]; }
    }
};
struct EpiLora1 {
    static constexpr bool PERM = true, AFTER_DRAIN = false;
    bf16_t* out;
    __device__ __forceinline__ void operator()(AccT acc, const Unit& u, int wr, int wc, int fr, int fq) const {
        bf16_t* o = out + (size_t)u.sub * ((size_t)T * 128); const int row0 = u.pm * BM + wr * 64 + fr, cw = wc * 32 + 8 * fq;
#pragma unroll
        EPI_ROWLOOP { float v[8];
#pragma unroll
            for (int n = 0; n < 2; ++n)
#pragma unroll
                for (int j = 0; j < 4; ++j) { float x = acc[ai][0][m][n][j];
                    if (u.sub == 0) x = 1.f - 2.f * __builtin_amdgcn_rcpf(1.f + __expf(2.f * x)); else if (u.sub == 2) x = sigmoidf_(x);
                    v[n * 4 + j] = x; }
            u32x4 w; w.x = cvt_pk_bf16(v[0], v[1]); w.y = cvt_pk_bf16(v[2], v[3]); w.z = cvt_pk_bf16(v[4], v[5]); w.w = cvt_pk_bf16(v[6], v[7]);
            *(u32x4*)(o + (size_t)(row0 + ai * HALF + m * 16) * 128 + cw) = w; }
    }
};
struct EpiLora2 {
    static constexpr bool PERM = false, AFTER_DRAIN = false;
    bf16_t* logw; bf16_t* iclr; bf16_t* gate; const float* w0; const float* a0;
    __device__ __forceinline__ void operator()(AccT acc, const Unit& u, int wr, int wc, int fr, int fq) const {
        const int row0 = u.pm * BM + wr * 64 + fr, col0 = u.pn * BM + wc * 32 + 4 * fq; const int kind = u.sub % 3, dir = u.sub / 3;
        if (kind == 0) {
            bf16_t* o = logw + (size_t)dir * T * D; const float* bp = w0 + dir * D + col0;
#pragma unroll
            for (int bj = 0; bj < 2; ++bj)
#pragma unroll
                for (int n = 0; n < 2; ++n) { const f32x4 bias = *(const f32x4*)(bp + bj * HALF + n * 16);
#pragma unroll
                    for (int ai = 0; ai < 2; ++ai)
#pragma unroll
                        for (int m = 0; m < 4; ++m) { const f32x4 x = acc[ai][bj][m][n] + bias; u32x2 w;
                            w.x = cvt_pk_bf16(-0.6065306597126334f * sigmoidf_(x[0]), -0.6065306597126334f * sigmoidf_(x[1])); w.y = cvt_pk_bf16(-0.6065306597126334f * sigmoidf_(x[2]), -0.6065306597126334f * sigmoidf_(x[3]));
                            *(u32x2*)(o + (size_t)(row0 + ai * HALF + m * 16) * D + col0 + bj * HALF + n * 16) = w; } }
        } else if (kind == 1) {
            bf16_t* o = iclr + (size_t)dir * T * D; const float* bp = a0 + dir * D + col0;
#pragma unroll
            for (int bj = 0; bj < 2; ++bj)
#pragma unroll
                for (int n = 0; n < 2; ++n) { const f32x4 bias = *(const f32x4*)(bp + bj * HALF + n * 16);
#pragma unroll
                    for (int ai = 0; ai < 2; ++ai)
#pragma unroll
                        for (int m = 0; m < 4; ++m) { const f32x4 x = acc[ai][bj][m][n] + bias; u32x2 w;
                            w.x = cvt_pk_bf16(sigmoidf_(x[0]), sigmoidf_(x[1])); w.y = cvt_pk_bf16(sigmoidf_(x[2]), sigmoidf_(x[3]));
                            *(u32x2*)(o + (size_t)(row0 + ai * HALF + m * 16) * D + col0 + bj * HALF + n * 16) = w; } }
        } else {
#pragma unroll
            for (int bj = 0; bj < 2; ++bj)
#pragma unroll
                for (int n = 0; n < 2; ++n)
#pragma unroll
                    for (int ai = 0; ai < 2; ++ai)
#pragma unroll
                        for (int m = 0; m < 4; ++m) { const f32x4 x = acc[ai][bj][m][n]; u32x2 w; w.x = cvt_pk_bf16(x[0], x[1]); w.y = cvt_pk_bf16(x[2], x[3]);
                            *(u32x2*)(gate + (size_t)(row0 + ai * HALF + m * 16) * D + col0 + bj * HALF + n * 16) = w; }
        }
    }
};
struct EpiSoftmax {
    static constexpr bool PERM = true, AFTER_DRAIN = true;
    bf16_t* P; const LAS float* rs; float scale;
    __device__ __forceinline__ void fused(f32x4 (&acc)[2][2][4][2], const Unit& u, int wr, int wc, int fr, int fq, LAS unsigned char* lds, int wid, int lane) const {
        LAS float* X1 = (LAS float*)lds;
        LAS float* X2 = (LAS float*)(lds + 4096);
        float mx[2][4];
#pragma unroll
        EPI_ROWLOOP { const float sc = scale * rs[ai * HALF + wr * 64 + m * 16 + fr];
#pragma unroll
            for (int bj = 0; bj < 2; ++bj)
#pragma unroll
                for (int n = 0; n < 2; ++n) acc[ai][bj][m][n] = acc[ai][bj][m][n] * sc; }
#pragma unroll
        EPI_ROWLOOP { float v = -3.0e38f;
#pragma unroll
            for (int bj = 0; bj < 2; ++bj)
#pragma unroll
                for (int n = 0; n < 2; ++n)
#pragma unroll
                    for (int j = 0; j < 4; ++j) v = fmaxf(v, acc[ai][bj][m][n][j]);
            v = fmaxf(v, __shfl_xor(v, 16)); v = fmaxf(v, __shfl_xor(v, 32));
            if (fq == 0) X1[(ai * HALF + wr * 64 + m * 16 + fr) * 4 + wc] = v; }
        asm volatile("s_waitcnt lgkmcnt(0)" ::: "memory"); __builtin_amdgcn_s_barrier(); asm volatile("" ::: "memory");
#pragma unroll
        EPI_ROWLOOP { const f32x4 p = *(const LAS f32x4*)(X1 + (ai * HALF + wr * 64 + m * 16 + fr) * 4); mx[ai][m] = fmaxf(fmaxf(p[0], p[1]), fmaxf(p[2], p[3])); }
#pragma unroll
        EPI_ROWLOOP { float s = 0.f;
#pragma unroll
            for (int bj = 0; bj < 2; ++bj)
#pragma unroll
                for (int n = 0; n < 2; ++n)
#pragma unroll
                    for (int j = 0; j < 4; ++j) { const float e = __builtin_amdgcn_exp2f(acc[ai][bj][m][n][j] - mx[ai][m]); acc[ai][bj][m][n][j] = e; s += e; }
            s += __shfl_xor(s, 16); s += __shfl_xor(s, 32);
            if (fq == 0) X2[(ai * HALF + wr * 64 + m * 16 + fr) * 4 + wc] = s; }
        asm volatile("s_waitcnt lgkmcnt(0)" ::: "memory"); __builtin_amdgcn_s_barrier(); asm volatile("" ::: "memory");
        const int row0 = u.pm * BM + wr * 64 + fr, col0 = u.pn * BM + wc * 32 + 8 * fq;
#pragma unroll
        EPI_ROWLOOP { const f32x4 p = *(const LAS f32x4*)(X2 + (ai * HALF + wr * 64 + m * 16 + fr) * 4); const float inv = __builtin_amdgcn_rcpf((p[0] + p[1]) + (p[2] + p[3]));
            bf16_t* rowp = P + (size_t)(row0 + ai * HALF + m * 16) * 1024 + col0;
#pragma unroll
            for (int bj = 0; bj < 2; ++bj) { const f32x4 v0 = acc[ai][bj][m][0] * inv, v1 = acc[ai][bj][m][1] * inv; u32x4 w;
                w.x = cvt_pk_bf16(v0[0], v0[1]); w.y = cvt_pk_bf16(v0[2], v0[3]); w.z = cvt_pk_bf16(v1[0], v1[1]); w.w = cvt_pk_bf16(v1[2], v1[3]); *(u32x4*)(rowp + bj * HALF) = w; } }
        asm volatile("s_waitcnt lgkmcnt(0)" ::: "memory"); __builtin_amdgcn_s_barrier(); asm volatile("" ::: "memory");
    }
};
}

#define XB_TMO      128
#define XB_XCNT(j)  (256  + 64 * (j))
#define XB_XSUB(j)  (1280 + 64 * (j))
#define XB_XGEN(j)  (2304 + 64 * (j))
#define XB_TOP      3328
#define XB_TOPGEN   3392
#define XCD_BAR_WORDS 3456
#define XB_SPIN_CAP (1u << 22)
__device__ __forceinline__ unsigned xb_ld(unsigned* p)              { return __hip_atomic_load(p, __ATOMIC_RELAXED, __HIP_MEMORY_SCOPE_AGENT); }
__device__ __forceinline__ unsigned xb_add(unsigned* p, unsigned v) { return __hip_atomic_fetch_add(p, v, __ATOMIC_RELAXED, __HIP_MEMORY_SCOPE_AGENT); }
__device__ __forceinline__ unsigned xb_xcc_id() { return (unsigned)__builtin_amdgcn_s_getreg((3 << 11) | 20) & 0xFu; }
#define XB_SPIN(cond, bar) do { unsigned _sp = 0; while (cond) { __builtin_amdgcn_s_sleep(1); \
    if ((++_sp & 255u) == 0u) { if (xb_ld(&(bar)[XB_TMO])) break; if (_sp > XB_SPIN_CAP) { atomicAdd(&(bar)[XB_TMO], 1u); break; } } } } while (0)
struct XcdBarrier { unsigned* bar; unsigned x; volatile LAS unsigned* st; };
__device__ __forceinline__ XcdBarrier xcd_barrier_post(unsigned* bar, volatile LAS unsigned* st) {
    XcdBarrier b; b.bar = bar; b.x = xb_xcc_id(); b.st = st;
    if (threadIdx.x == 0) (void)xb_add(&bar[XB_XCNT(b.x)], 1u);
    return b;
}
__device__ __forceinline__ void xcd_barrier_complete(unsigned* bar, unsigned x, unsigned& nloc, unsigned& nx) {
    const unsigned G = gridDim.x * gridDim.y * gridDim.z;
    unsigned sum, cnt, mine, sp = 0u;
    for (;;) {
        sum = 0u; cnt = 0u; mine = 0u;
#pragma unroll
        for (unsigned j = 0; j < 16; ++j) { const unsigned c = xb_ld(&bar[XB_XCNT(j)]); sum += c; cnt += (c > 0u) ? 1u : 0u; mine = (j == x) ? c : mine; }
        if (sum == G) break;
        __builtin_amdgcn_s_sleep(1);
        if ((++sp & 255u) == 0u) { if (xb_ld(&bar[XB_TMO])) break; if (sp > XB_SPIN_CAP) { atomicAdd(&bar[XB_TMO], 1u); break; } }
    }
    nloc = mine > 0u ? mine : 1u; nx = cnt > 0u ? cnt : 1u;
}
__device__ __forceinline__ void xcd_barrier(const XcdBarrier& b) {
    asm volatile("s_waitcnt vmcnt(0)" ::: "memory");
    __syncthreads();
    if (threadIdx.x == 0) {
        unsigned* bar = b.bar; asm volatile("" : "+v"(bar));
        __builtin_amdgcn_s_waitcnt(0);
        unsigned nloc = b.st[0], nx = b.st[1];
        if (nloc == 0u) { xcd_barrier_complete(bar, b.x, nloc, nx); b.st[0] = nloc; b.st[1] = nx; }
        const unsigned old = xb_add(&bar[XB_XSUB(b.x)], 1u);
        const unsigned gen = old / nloc;
        if (old + 1u == (gen + 1u) * nloc) {
            __builtin_amdgcn_fence(__ATOMIC_RELEASE, "agent");
            asm volatile("s_waitcnt vmcnt(0)" ::: "memory");
            const unsigned og = xb_add(&bar[XB_TOP], 1u);
            const unsigned tg = og / nx;
            if (og + 1u == (tg + 1u) * nx) xb_add(&bar[XB_TOPGEN], 1u);
            else XB_SPIN(xb_ld(&bar[XB_TOPGEN]) == tg, bar);
            __builtin_amdgcn_fence(__ATOMIC_ACQUIRE, "agent");
            xb_add(&bar[XB_XGEN(b.x)], 1u);
            asm volatile("s_waitcnt vmcnt(0)" ::: "memory");
        } else {
            XB_SPIN(xb_ld(&bar[XB_XGEN(b.x)]) == gen, bar);
            __builtin_amdgcn_fence(__ATOMIC_ACQUIRE, "agent");
            asm volatile("s_waitcnt vmcnt(0)" ::: "memory");
        }
    }
    __syncthreads();
}

struct Args { const float* in[34]; float* out; unsigned char* ws; int ph_lo, ph_hi, dbg, pad; };
struct Frame {
    LAS unsigned char* lds;
    int tid, lane, wave, G, gw, NGW;
    unsigned char* ws;
};
__device__ __forceinline__ const float* inp(const struct Args& a, int k);
enum { I_X = 0, I_MEM, I_NMIX, I_NXATTN, I_NMEM, I_NFFN, I_NFINAL, I_CONV_WIN, I_CONV_W, I_CONV_WOUT, I_MU, I_WRKV, I_W0, I_W1, I_W2, I_A0, I_A1, I_A2, I_G1, I_G2,
       I_KK, I_KA, I_RK, I_LNW, I_LNB, I_RWOUT, I_XWQ, I_XWKV, I_XWO, I_ROUTER, I_WGATE, I_WUP, I_WDOWN, I_WS };

__device__ __forceinline__ const float* inp(const Args& a, int k) { asm volatile("" : "+s"(k)); return a.in[k]; }
__device__ __forceinline__ void convert_item(const float* src, int ld_src, int k0, int n0, bf16_t* dst, int ld_dst, int drow0, int dk0, LAS float* scr, int lane, const float* gk = nullptr) {
    { f32x4 t[8]; const int kq = lane >> 3, nq = 4 * (lane & 7);
#pragma unroll
        for (int i = 0; i < 8; ++i) t[i] = *(const f32x4*)(src + (size_t)(k0 + 8 * i + kq) * ld_src + n0 + nq);
        if (gk) {
#pragma unroll
            for (int i = 0; i < 8; ++i) t[i] = t[i] * gk[k0 + 8 * i + kq]; }
#pragma unroll
        for (int i = 0; i < 8; ++i) { LAS float* d = scr + (8 * i + kq) * 33 + nq; d[0] = t[i][0]; d[1] = t[i][1]; d[2] = t[i][2]; d[3] = t[i][3]; } }
    LDS_WAIT(); asm volatile("" ::: "memory");
    const int c = lane & 7;
#pragma unroll
    for (int j = 0; j < 4; ++j) { const int n = (lane >> 3) + 8 * j; const LAS float* s = scr + (8 * c) * 33 + n;
        u32x4 o; o.x = pk2(s[0 * 33], s[1 * 33]); o.y = pk2(s[2 * 33], s[3 * 33]); o.z = pk2(s[4 * 33], s[5 * 33]); o.w = pk2(s[6 * 33], s[7 * 33]);
        *(u32x4*)(dst + (size_t)(drow0 + n) * ld_dst + dk0 + k0 + 8 * c) = o; }
    LDS_WAIT(); asm volatile("" ::: "memory");
}
__device__ __forceinline__ void convert_item8(const float* src, int ld_src, int k0, int n0, unsigned char* dst, int ld_dst, int drow0, float scale, LAS float* scr, int lane) {
    { f32x4 t[8]; const int kq = lane >> 3, nq = 4 * (lane & 7);
#pragma unroll
        for (int i = 0; i < 8; ++i) t[i] = *(const f32x4*)(src + (size_t)(k0 + 8 * i + kq) * ld_src + n0 + nq);
#pragma unroll
        for (int i = 0; i < 8; ++i) { LAS float* d = scr + (8 * i + kq) * 33 + nq; d[0] = t[i][0]; d[1] = t[i][1]; d[2] = t[i][2]; d[3] = t[i][3]; } }
    LDS_WAIT(); asm volatile("" ::: "memory");
    const int n = lane & 31, hf = lane >> 5; const LAS float* s = scr + (32 * hf) * 33 + n;
    unsigned char* d = dst + (size_t)(drow0 + n) * ld_dst + k0 + 32 * hf;
#pragma unroll
    for (int q = 0; q < 2; ++q) { u32x4 o;
        o.x = pk_fp8x4(s[(16 * q + 0) * 33] * scale, s[(16 * q + 1) * 33] * scale, s[(16 * q + 2) * 33] * scale, s[(16 * q + 3) * 33] * scale);
        o.y = pk_fp8x4(s[(16 * q + 4) * 33] * scale, s[(16 * q + 5) * 33] * scale, s[(16 * q + 6) * 33] * scale, s[(16 * q + 7) * 33] * scale);
        o.z = pk_fp8x4(s[(16 * q + 8) * 33] * scale, s[(16 * q + 9) * 33] * scale, s[(16 * q + 10) * 33] * scale, s[(16 * q + 11) * 33] * scale);
        o.w = pk_fp8x4(s[(16 * q + 12) * 33] * scale, s[(16 * q + 13) * 33] * scale, s[(16 * q + 14) * 33] * scale, s[(16 * q + 15) * 33] * scale);
        *(u32x4*)(d + 16 * q) = o; }
    LDS_WAIT(); asm volatile("" ::: "memory");
}
template <int MAP>
__device__ __forceinline__ void convert_matrix(const Frame& F, LAS float* scr, const float* src, int ld_src, int K, int N, bf16_t* dst, int ld_dst, int drow_base, int dk0) {
    const int nnb = N / 32, nitems = (K / 64) * nnb;
    for (int it = F.gw; it < nitems; it += F.NGW) { const int kb = it / nnb, nb = it - kb * nnb, n0 = nb * 32;
        const int drow = MAP == 0 ? drow_base + n0 : (n0 / 128) * 256 + (n0 % 128) + drow_base;
        convert_item(src, ld_src, kb * 64, n0, dst, ld_dst, drow, dk0, scr, F.lane); }
}
__device__ __forceinline__ void zero_region(const Frame& F, bf16_t* dst, int ld, int r0, int nr, int k0, int nk) {
    const int per = nk / 8, total = nr * per; const int gt = F.gw * 64 + F.lane, NT = F.NGW * 64;
    for (int i = gt; i < total; i += NT) { const int r = i / per, c = i - r * per; *(u32x4*)(dst + (size_t)(r0 + r) * ld + k0 + c * 8) = (u32x4){0u, 0u, 0u, 0u}; }
}

__device__ __forceinline__ void row_load(const float* p, int lane, f32x4 (&v)[4]) {
#pragma unroll
    for (int j = 0; j < 4; ++j) v[j] = *(const f32x4*)(p + 4 * lane + 256 * j);
}
__device__ __forceinline__ void row_store_f32(float* p, int lane, const f32x4 (&v)[4]) {
#pragma unroll
    for (int j = 0; j < 4; ++j) *(f32x4*)(p + 4 * lane + 256 * j) = v[j];
}
__device__ __forceinline__ void row_store_bf16(bf16_t* p, int lane, const f32x4 (&v)[4]) {
#pragma unroll
    for (int j = 0; j < 4; ++j) { u32x2 w; w.x = pk2(v[j][0], v[j][1]); w.y = pk2(v[j][2], v[j][3]); __builtin_nontemporal_store(w, (u32x2*)(p + 4 * lane + 256 * j)); }
}
__device__ __forceinline__ void row_store_fp8(unsigned char* p, int lane, const f32x4 (&v)[4], float scale) {
#pragma unroll
    for (int j = 0; j < 4; ++j) __builtin_nontemporal_store(pk_fp8x4(v[j][0] * scale, v[j][1] * scale, v[j][2] * scale, v[j][3] * scale), (unsigned*)(p + 4 * lane + 256 * j));
}
__device__ __forceinline__ void row_load_b16(const bf16_t* p, int lane, f32x4 (&v)[4]) {
#pragma unroll
    for (int j = 0; j < 4; ++j) { const u32x2 w = *(const u32x2*)(p + 4 * lane + 256 * j); v[j][0] = bf_lo(w.x); v[j][1] = bf_hi(w.x); v[j][2] = bf_lo(w.y); v[j][3] = bf_hi(w.y); }
}
__device__ __forceinline__ void row_load_bf16_add(const bf16_t* p, int lane, f32x4 (&v)[4]) {
#pragma unroll
    for (int j = 0; j < 4; ++j) { const u32x2 w = *(const u32x2*)(p + 4 * lane + 256 * j); v[j][0] += bf_lo(w.x); v[j][1] += bf_hi(w.x); v[j][2] += bf_lo(w.y); v[j][3] += bf_hi(w.y); }
}
__device__ __forceinline__ float row_sumsq(const f32x4 (&v)[4]) {
    float s = 0.f;
#pragma unroll
    for (int j = 0; j < 4; ++j) s += (v[j][0] * v[j][0] + v[j][1] * v[j][1]) + (v[j][2] * v[j][2] + v[j][3] * v[j][3]);
    return wave_sum(s);
}
__device__ __forceinline__ void row_rmsnorm(f32x4 (&v)[4], const float* g, int lane) {
    const float r = __builtin_amdgcn_rsqf(row_sumsq(v) * (1.f / D) + RMS_EPS);
#pragma unroll
    for (int j = 0; j < 4; ++j) { const f32x4 gg = *(const f32x4*)(g + 4 * lane + 256 * j); v[j] = v[j] * r * gg; }
}
template <bool COMBINE>
__device__ __forceinline__ void row_fetch(const bf16_t* Hin, const bf16_t* YE, const int* SLOT, int m, int lane, f32x4 (&v)[4]) {
    row_load_b16(Hin + (size_t)m * D, lane, v);
    if (COMBINE) {
        const int b = m / SEQ, t = m - b * SEQ;
        const int sl = (lane < NE) ? SLOT[((size_t)b * NE + lane) * SEQ + t] : -1;
        unsigned long long mask = __ballot(sl >= 0);
        while (mask) {
            const int e0 = __builtin_ctzll(mask); mask &= mask - 1; const int s0 = __shfl(sl, e0);
            const bf16_t* p0 = YE + ((size_t)(e0 * NB + b) * CAP + s0) * D;
            if (mask) { const int e1 = __builtin_ctzll(mask); mask &= mask - 1; const int s1 = __shfl(sl, e1);
                const bf16_t* p1 = YE + ((size_t)(e1 * NB + b) * CAP + s1) * D; u32x2 w0[4], w1[4];
#pragma unroll
                for (int j = 0; j < 4; ++j) { w0[j] = *(const u32x2*)(p0 + 4 * lane + 256 * j); w1[j] = *(const u32x2*)(p1 + 4 * lane + 256 * j); }
#pragma unroll
                for (int j = 0; j < 4; ++j) { v[j][0] += bf_lo(w0[j].x) + bf_lo(w1[j].x); v[j][1] += bf_hi(w0[j].x) + bf_hi(w1[j].x); v[j][2] += bf_lo(w0[j].y) + bf_lo(w1[j].y); v[j][3] += bf_hi(w0[j].y) + bf_hi(w1[j].y); }
            } else row_load_bf16_add(p0, lane, v);
        }
    }
}

struct CJob { int in_idx, src_off, ld_src, K, N, dst_off, ld_dst, drow, dk0, map, first, g_idx, g_off; };
struct CJobTable { CJob j[64]; int n, total; };
constexpr CJobTable make_cjobs() {
    CJobTable t{}; int n = 0, tot = 0;
    auto add = [&](int in_idx, size_t src_off, int ld_src, int K, int N, size_t dst_bytes, int ld_dst, int drow, int dk0, int map, int g_idx = -1, int g_off = 0) {
        t.j[n] = CJob{in_idx, (int)src_off, ld_src, K, N, (int)(dst_bytes - WS_W), ld_dst, drow, dk0, map, tot, g_idx, g_off}; tot += (K / 64) * (N / 32); ++n; };
    for (int j = 0; j < 2; ++j) {
        add(I_CONV_WIN, (size_t)j * 1024 * 3072, 3072, 1024, 1024, WS_CONVIN + j * SZ_CONVIN, 1024, 2048, 0, 0);
        add(I_CONV_WIN, (size_t)j * 1024 * 3072 + 1024, 3072, 1024, 1024, WS_CONVIN + j * SZ_CONVIN, 1024, 0, 0, 1);
        add(I_CONV_WIN, (size_t)j * 1024 * 3072 + 2048, 3072, 1024, 1024, WS_CONVIN + j * SZ_CONVIN, 1024, 128, 0, 1);
        add(I_CONV_WOUT, (size_t)j * 1024 * 1024, 1024, 1024, 1024, WS_CONVOUT + j * SZ_SQ, 1024, 0, 0, 0);
    }
    for (int j = 0; j < 2; ++j) {
        for (int q = 0; q < 3; ++q) add(I_WRKV, (size_t)(j * 3 + q) * 1024 * 1024, 1024, 1024, 1024, WS_RKV + (j * 3 + q) * SZ_SQ, 1024, 0, 0, 0);
        for (int dir = 0; dir < 2; ++dir) {
            add(I_W1, (size_t)(j * 2 + dir) * 1024 * 64, 64, 1024, 64, WS_L1 + j * SZ_L1, 1024, dir * 64, 0, 0);
            add(I_A1, (size_t)(j * 2 + dir) * 1024 * 64, 64, 1024, 64, WS_L1 + j * SZ_L1, 1024, 256 + dir * 64, 0, 0);
            add(I_W2, (size_t)(j * 2 + dir) * 64 * 1024, 1024, 64, 1024, WS_L2 + j * SZ_L2 + (size_t)(dir * 3 + 0) * 1024 * 128 * 2, 128, 0, dir * 64, 0);
            add(I_A2, (size_t)(j * 2 + dir) * 64 * 1024, 1024, 64, 1024, WS_L2 + j * SZ_L2 + (size_t)(dir * 3 + 1) * 1024 * 128 * 2, 128, 0, dir * 64, 0);
        }
        add(I_G1, (size_t)j * 1024 * 128, 128, 1024, 128, WS_L1 + j * SZ_L1, 1024, 512, 0, 0);
        add(I_G2, (size_t)j * 128 * 1024, 1024, 128, 1024, WS_L2 + j * SZ_L2 + (size_t)2 * 1024 * 128 * 2, 128, 0, 0, 0);
        add(I_RWOUT, (size_t)j * 1024 * 1024, 1024, 1024, 1024, WS_ROUT + j * SZ_SQ, 1024, 0, 0, 0);
    }
    for (int i = 0; i < 4; ++i) {
        add(I_XWKV, (size_t)i * 1024 * 2048, 2048, 1024, 2048, WS_WKV + i * 2 * SZ_SQ, 1024, 0, 0, 0);
        add(I_XWO, (size_t)i * 1024 * 1024, 1024, 1024, 1024, WS_WO + i * SZ_SQ, 1024, 0, 0, 0);
    }
    t.n = n; t.total = tot; return t;
}
__constant__ const CJobTable c_jobs = make_cjobs();
__device__ __forceinline__ void phase_prologue(const Frame& F, const Args& A) {
    LAS float* scr = (LAS float*)(F.lds + F.wave * 16384);
    unsigned char* ws = F.ws;
    for (int it = F.gw; it < c_jobs.total; it += F.NGW) {
        int jn = 0;
        for (int q = 1; q < c_jobs.n; ++q) jn = (it >= c_jobs.j[q].first) ? q : jn;
        const CJob jb = c_jobs.j[jn];
        const int li = it - jb.first, nnb = jb.N / 32, kb = li / nnb, nb = li - kb * nnb, n0 = nb * 32;
        const int drow = jb.map == 0 ? jb.drow + n0 : (n0 / 128) * 256 + (n0 % 128) + jb.drow;
        const float* gk = nullptr; if (jb.g_idx >= 0) gk = inp(A, jb.g_idx) + jb.g_off;
        convert_item(inp(A, jb.in_idx) + jb.src_off, jb.ld_src, kb * 64, n0, (bf16_t*)(ws + WS_W + jb.dst_off), jb.ld_dst, drow, jb.dk0, scr, F.lane, gk);
    }
    for (int j = 0; j < 2; ++j) {
        bf16_t* l1 = (bf16_t*)(ws + WS_L1 + j * SZ_L1);
        zero_region(F, l1, 1024, 128, 128, 0, 1024); zero_region(F, l1, 1024, 384, 128, 0, 1024); zero_region(F, l1, 1024, 640, 128, 0, 1024);
        bf16_t* l2 = (bf16_t*)(ws + WS_L2 + j * SZ_L2);
        for (int dir = 0; dir < 2; ++dir) { zero_region(F, l2 + (size_t)(dir * 3 + 0) * 1024 * 128, 128, 0, 1024, (1 - dir) * 64, 64); zero_region(F, l2 + (size_t)(dir * 3 + 1) * 1024 * 128, 128, 0, 1024, (1 - dir) * 64, 64); }
    }
    for (int idx = F.gw; idx < 4 * 1024; idx += F.NGW) { f32x4 v[4];
        row_load(inp(A, I_XWQ) + (size_t)idx * D, F.lane, v); const float gd = inp(A, I_NXATTN)[idx];
#pragma unroll
        for (int jj = 0; jj < 4; ++jj) v[jj] = v[jj] * gd;
        row_store_bf16((bf16_t*)(ws + WS_WQ) + (size_t)idx * D, F.lane, v); }
    for (int idx = F.gw; idx < 4 * 1024; idx += F.NGW) { const int l = idx >> 10, r = idx & 1023; f32x4 v[4];
        row_load(inp(A, I_MEM) + (size_t)r * D, F.lane, v); row_rmsnorm(v, inp(A, I_NMEM) + l * D, F.lane); row_store_bf16((bf16_t*)(ws + WS_MEMN) + (size_t)idx * D, F.lane, v); }
    for (int m = 2 * F.gw; m < T; m += 2 * F.NGW) { f32x4 v[4], w[4];
        row_load(inp(A, I_X) + (size_t)m * D, F.lane, v); row_load(inp(A, I_X) + (size_t)(m + 1) * D, F.lane, w); row_rmsnorm(v, inp(A, I_NMIX), F.lane); row_rmsnorm(w, inp(A, I_NMIX), F.lane);
        row_store_bf16((bf16_t*)(ws + WS_XN) + (size_t)m * D, F.lane, v); row_store_bf16((bf16_t*)(ws + WS_XN) + (size_t)(m + 1) * D, F.lane, w); }
}
__device__ __forceinline__ void moe_convert(const Frame& F, const Args& A, int i, int cgw, int CNGW) {
    LAS float* scr = (LAS float*)(F.lds + F.wave * 16384);
    const float* wg = inp(A, I_WGATE); const float* wu = inp(A, I_WUP); const float* wd = inp(A, I_WDOWN);
    for (int it = cgw; it < NE * 3 * 512; it += CNGW) {
        const int e = it / 1536, r = it - e * 1536, mat = r >> 9, q = r & 511, kb = q >> 5, nb = q & 31, n0 = nb * 32;
        const size_t so = (size_t)(i * NE + e) * 1024 * 1024;
        if (mat < 2) convert_item8((mat == 0 ? wg : wu) + so, 1024, kb * 64, n0, F.ws + WS_WGU + (size_t)e * 2048 * 1024, 1024, (n0 / 128) * 256 + (n0 % 128) + mat * 128, FP8_SW, scr, F.lane);
        else convert_item8(wd + so, 1024, kb * 64, n0, F.ws + WS_WD + (size_t)e * 1024 * 1024, 1024, n0, FP8_SW, scr, F.lane);
    }
}
__device__ __forceinline__ void phase_norm(const Frame& F, const bf16_t* H, const float* g, bf16_t* XN) {
    for (int m = 2 * F.gw; m < T; m += 2 * F.NGW) { f32x4 v[4], w[4]; row_load_b16(H + (size_t)m * D, F.lane, v); row_load_b16(H + (size_t)(m + 1) * D, F.lane, w);
        row_rmsnorm(v, g, F.lane); row_rmsnorm(w, g, F.lane); row_store_bf16(XN + (size_t)m * D, F.lane, v); row_store_bf16(XN + (size_t)(m + 1) * D, F.lane, w); }
}
template <int MODE>
__device__ __forceinline__ void phase_entry_plain(const Frame& F, const bf16_t* Hin, bf16_t* Hout, const bf16_t* YE, const int* SLOT, const float* g, bf16_t* XN, float* outf) {
    for (int m0 = 2 * F.gw; m0 < T; m0 += 2 * F.NGW) { f32x4 v[4], w[4]; row_fetch<true>(Hin, YE, SLOT, m0, F.lane, v); row_fetch<true>(Hin, YE, SLOT, m0 + 1, F.lane, w);
        if (MODE == 0) { row_store_bf16(Hout + (size_t)m0 * D, F.lane, v); row_store_bf16(Hout + (size_t)(m0 + 1) * D, F.lane, w); }
        row_rmsnorm(v, g, F.lane); row_rmsnorm(w, g, F.lane);
        if (MODE == 0) { row_store_bf16(XN + (size_t)m0 * D, F.lane, v); row_store_bf16(XN + (size_t)(m0 + 1) * D, F.lane, w); }
        else { row_store_f32(outf + (size_t)m0 * D, F.lane, v); row_store_f32(outf + (size_t)(m0 + 1) * D, F.lane, w); } }
}
__device__ __forceinline__ void phase_entry_rwkv(const Frame& F, const bf16_t* Hin, bf16_t* Hout, const bf16_t* YE, const int* SLOT, const float* g, const float* mu, bf16_t* X6) {
    const int lane = F.lane;
    for (int ck = F.gw; ck < T / 8; ck += F.NGW) {
        const int m0 = ck * 8, t0 = m0 % SEQ;
        f32x4 prev[4], cur[4], nxt[4];
        if (t0 > 0) { row_fetch<true>(Hin, YE, SLOT, m0 - 1, lane, prev); row_rmsnorm(prev, g, lane); }
        else {
#pragma unroll
            for (int j = 0; j < 4; ++j) prev[j] = (f32x4){0.f, 0.f, 0.f, 0.f}; }
        row_fetch<true>(Hin, YE, SLOT, m0, lane, cur); row_store_bf16(Hout + (size_t)m0 * D, lane, cur); row_rmsnorm(cur, g, lane);
        for (int i = 0; i < 8; ++i) {
            const int m = m0 + i;
            if (t0 + i + 1 < SEQ) { row_fetch<true>(Hin, YE, SLOT, m + 1, lane, nxt); if (i + 1 < 8) row_store_bf16(Hout + (size_t)(m + 1) * D, lane, nxt); row_rmsnorm(nxt, g, lane); }
            else {
#pragma unroll
                for (int j = 0; j < 4; ++j) nxt[j] = (f32x4){0.f, 0.f, 0.f, 0.f}; }
#pragma unroll
            for (int j = 0; j < 4; ++j) { const f32x4 xx = (prev[j] + nxt[j]) * 0.5f - cur[j];
#pragma unroll
                for (int s = 0; s < 6; ++s) { const f32x4 mv = *(const f32x4*)(mu + s * D + 4 * lane + 256 * j); const f32x4 o = cur[j] + xx * mv;
                    u32x2 w; w.x = pk2(o[0], o[1]); w.y = pk2(o[2], o[3]); __builtin_nontemporal_store(w, (u32x2*)(X6 + (size_t)s * T * D + (size_t)m * D + 4 * lane + 256 * j)); } }
#pragma unroll
            for (int j = 0; j < 4; ++j) { prev[j] = cur[j]; cur[j] = nxt[j]; }
        }
    }
}
__device__ __forceinline__ void phase_mix(const Frame& F, const bf16_t* XN, const float* mu, bf16_t* X6) {
    const int gt = F.gw * 64 + F.lane, NT = F.NGW * 64;
    for (int idx = gt; idx < T * (D / 8); idx += NT) {
        const int m = idx >> 7, c8 = (idx & 127) * 8, t = m & (SEQ - 1);
        const size_t off = (size_t)m * D + c8; const u32x4 z = (u32x4){0u, 0u, 0u, 0u};
        const u32x4 xp = t > 0 ? *(const u32x4*)(XN + off - D) : z, xc = *(const u32x4*)(XN + off), xq = t < SEQ - 1 ? *(const u32x4*)(XN + off + D) : z;
        float cur[8], xx[8];
#pragma unroll
        for (int q = 0; q < 4; ++q) { cur[2 * q] = bf_lo(xc[q]); cur[2 * q + 1] = bf_hi(xc[q]);
            xx[2 * q] = 0.5f * (bf_lo(xp[q]) + bf_lo(xq[q])) - cur[2 * q]; xx[2 * q + 1] = 0.5f * (bf_hi(xp[q]) + bf_hi(xq[q])) - cur[2 * q + 1]; }
#pragma unroll
        for (int sidx = 0; sidx < 6; ++sidx) { const f32x4 m0 = *(const f32x4*)(mu + sidx * D + c8), m1 = *(const f32x4*)(mu + sidx * D + c8 + 4); u32x4 w;
            w.x = pk2(cur[0] + xx[0] * m0[0], cur[1] + xx[1] * m0[1]); w.y = pk2(cur[2] + xx[2] * m0[2], cur[3] + xx[3] * m0[3]);
            w.z = pk2(cur[4] + xx[4] * m1[0], cur[5] + xx[5] * m1[1]); w.w = pk2(cur[6] + xx[6] * m1[2], cur[7] + xx[7] * m1[3]);
            __builtin_nontemporal_store(w, (u32x4*)(X6 + (size_t)sidx * T * D + off)); }
    }
}
__device__ __forceinline__ void phase_conv_ew(const Frame& F, const bf16_t* U, const bf16_t* BG, const float* cw, bf16_t* G) {
    const int gt = F.gw * 64 + F.lane, NT = F.NGW * 64;
    for (int idx = gt; idx < T * (D / 8); idx += NT) {
        const int m = idx >> 7, c8 = (idx & 127) * 8, t = m & (SEQ - 1);
        const size_t off = (size_t)m * D + c8;
        const u32x4 z = (u32x4){0u, 0u, 0u, 0u};
        const u32x4 u0 = t > 0 ? *(const u32x4*)(U + off - D) : z, u1 = *(const u32x4*)(U + off), u2 = t < SEQ - 1 ? *(const u32x4*)(U + off + D) : z, bg = *(const u32x4*)(BG + off);
        float o[8];
#pragma unroll
        for (int q = 0; q < 4; ++q) {
            const float w0a = cw[c8 + 2 * q], w0b = cw[c8 + 2 * q + 1], w1a = cw[D + c8 + 2 * q], w1b = cw[D + c8 + 2 * q + 1], w2a = cw[2 * D + c8 + 2 * q], w2b = cw[2 * D + c8 + 2 * q + 1];
            o[2 * q] = bf_lo(bg[q]) * (bf_lo(u0[q]) * w0a + bf_lo(u1[q]) * w1a + bf_lo(u2[q]) * w2a);
            o[2 * q + 1] = bf_hi(bg[q]) * (bf_hi(u0[q]) * w0b + bf_hi(u1[q]) * w1b + bf_hi(u2[q]) * w2b); }
        u32x4 w; w.x = pk2(o[0], o[1]); w.y = pk2(o[2], o[3]); w.z = pk2(o[4], o[5]); w.w = pk2(o[6], o[7]); __builtin_nontemporal_store(w, (u32x4*)(G + off));
    }
}
__device__ __forceinline__ void phase_router(const Frame& F, const bf16_t* H, const float* g, const float* router, unsigned char* XN8, float* PROBS, int mb, int me, int ms) {
    LAS f32x4* RL = (LAS f32x4*)F.lds;
    for (int u = F.tid; u < 4096; u += NTHREADS) { const int l = u & 63, q = (u >> 6) & 3, ii = (u >> 8) & 3, j = u >> 10; RL[u] = *(const f32x4*)(router + (size_t)(4 * l + 256 * j + ii) * NE + 4 * q); }
    __syncthreads();
    const int lane = F.lane;
    for (int m = mb; m < me; m += ms) {
        f32x4 v[4]; row_load_b16(H + (size_t)m * D, lane, v); row_rmsnorm(v, g, lane); row_store_fp8(XN8 + (size_t)m * D, lane, v, FP8_SX);
        float lg[NE];
#pragma unroll
        for (int e = 0; e < NE; ++e) lg[e] = 0.f;
#pragma unroll
        for (int j = 0; j < 4; ++j)
#pragma unroll
            for (int ii = 0; ii < 4; ++ii) { const float x = v[j][ii];
#pragma unroll
                for (int q = 0; q < 4; ++q) { const f32x4 w = RL[((j * 4 + ii) * 4 + q) * 64 + lane]; lg[4 * q] += x * w[0]; lg[4 * q + 1] += x * w[1]; lg[4 * q + 2] += x * w[2]; lg[4 * q + 3] += x * w[3]; }
                __builtin_amdgcn_sched_barrier(0); }
        const float lt = reduce_scatter16(lg, lane);
        float mx = lt;
#pragma unroll
        for (int o = 1; o < 64; o <<= 1) mx = fmaxf(mx, __shfl_xor(mx, o));
        const float ex = expf(lt - mx);
        const float pe = ex / (wave_sum(ex) * 0.25f);
        const int b = m / SEQ, t = m - b * SEQ;
        if ((lane & 3) == 0) PROBS[((size_t)b * NE + rs16_index(lane)) * SEQ + t] = pe;
    }
    __syncthreads();
}
__device__ __forceinline__ int wave_incl_scan(int x, int lane) {
#pragma unroll
    for (int o = 1; o < 64; o <<= 1) { const int n = __shfl_up(x, o); if (lane >= o) x += n; }
    return x;
}
__device__ __forceinline__ int wave_sum_i(int v) {
#pragma unroll
    for (int o = 1; o < 64; o <<= 1) v += __shfl_xor(v, o);
    return v;
}
__device__ __forceinline__ int block_exscan(int v, LAS int* tmp, int lane, int wave, int& tot) {
    const int inc = wave_incl_scan(v, lane);
    __syncthreads();
    if (lane == 63) tmp[wave] = inc;
    __syncthreads();
    int off = 0, total = 0;
#pragma unroll
    for (int w = 0; w < NWAVES; ++w) { const int x = tmp[w]; total += x; off += (w < wave) ? x : 0; }
    tot = total; return off + inc - v;
}
__device__ __forceinline__ void select_pair(const Frame& F, int pair, const float* PROBS, int* SLOT, float* AFF, int* GIDX) {
    LAS int* cnt = (LAS int*)F.lds;
    LAS int* tmp = (LAS int*)(F.lds + 64);
    const int tid = F.tid, lane = F.lane, wave = F.wave;
    const int b = pair / NE, e = pair - b * NE, rowbase = (e * NB + b) * CAP;
    const float* p = PROBS + (size_t)pair * SEQ + tid * 8;
    const f32x4 p0 = *(const f32x4*)p, p1 = *(const f32x4*)(p + 4);
    unsigned key[8];
#pragma unroll
    for (int i = 0; i < 4; ++i) { const float fa = p0[i], fb = p1[i]; key[i] = __float_as_uint(fa); key[4 + i] = __float_as_uint(fb); }
    unsigned thr = 0u;
    for (int bit = 30; bit >= 0; --bit) {
        const unsigned cand = thr | (1u << bit); int c = 0;
#pragma unroll
        for (int i = 0; i < 8; ++i) c += (key[i] >= cand) ? 1 : 0;
        c = wave_sum_i(c);
        LAS int* slot = cnt + (bit & 1) * 8;
        if (lane == 0) slot[wave] = c;
        __syncthreads();
        int total = 0;
#pragma unroll
        for (int w = 0; w < NWAVES; ++w) total += slot[w];
        if (total >= CAP) thr = cand;
    }
    int ngt = 0, neq = 0;
#pragma unroll
    for (int i = 0; i < 8; ++i) { ngt += (key[i] > thr) ? 1 : 0; neq += (key[i] == thr) ? 1 : 0; }
    int tot_gt, tot_eq;
    const int gt_before = block_exscan(ngt, tmp, lane, wave, tot_gt); (void)gt_before;
    const int eq_before = block_exscan(neq, tmp, lane, wave, tot_eq);
    const int need = CAP - tot_gt;
    int sel = 0, eqr = eq_before, nsel = 0;
#pragma unroll
    for (int i = 0; i < 8; ++i) { bool s = key[i] > thr; if (key[i] == thr) { s = eqr < need; ++eqr; } if (s) { sel |= 1 << i; ++nsel; } }
    int tot_sel;
    int base = block_exscan(nsel, tmp, lane, wave, tot_sel);
#pragma unroll
    for (int i = 0; i < 8; ++i) { const int t = tid * 8 + i; int sl = -1;
        if (sel & (1 << i)) { sl = base++; GIDX[rowbase + sl] = b * SEQ + t; AFF[(size_t)rowbase + sl] = __uint_as_float(key[i]); }
        SLOT[(size_t)pair * SEQ + t] = sl; }
    __syncthreads();
}
__device__ __forceinline__ float red8(float v) { v += __shfl_xor(v, 1); v += __shfl_xor(v, 2); v += __shfl_xor(v, 4); return v; }
__device__ __forceinline__ float bf1(const bf16_t* p) { return __uint_as_float((unsigned)(*p) << 16); }
#ifdef DBG_WKV
__device__ __forceinline__ void phase_scan_seq(const Frame& F, const bf16_t* R, const bf16_t* Kx, const bf16_t* V, const float* LOGW, const bf16_t* ICLR,
                                               const float* kkw, const float* kaw, const float* rkw, float* Y) {
    const int lane = F.lane;
    for (int item = F.wave * F.G + (int)blockIdx.x; item < 1024; item += NWAVES * F.G) {
        const int chain = item >> 3, rg = item & 7, dir = chain >> 6, bh = chain & 63, b = bh >> 4, h = bh & 15;
        const int rloc = lane >> 3, ks = lane & 7, row = rg * 8 + rloc, c0 = h * 64 + ks * 8;
        float kkc[8], kac[8], S[8];
#pragma unroll
        for (int i = 0; i < 8; ++i) { kkc[i] = kkw[c0 + i]; kac[i] = kaw[c0 + i]; S[i] = 0.f; }
        const float* lwp = LOGW + (size_t)dir * T * D; const bf16_t* icp = ICLR + (size_t)dir * T * D; float* yp = Y + (size_t)dir * T * D;
        const int tfirst = dir ? SEQ - 1 : 0, tstep = dir ? -1 : 1;
        for (int step = 0; step < SEQ; ++step) {
            const int t = tfirst + tstep * step; const size_t m = (size_t)b * SEQ + t; const size_t off = m * D + c0;
            const u32x4 rr = *(const u32x4*)(R + off), kq = *(const u32x4*)(Kx + off), ic = *(const u32x4*)(icp + off);
            const f32x4 l0 = *(const f32x4*)(lwp + off), l1 = *(const f32x4*)(lwp + off + 4);
            const float vv = bf1(V + m * D + h * 64 + row);
            float r[8], k[8], lw[8], a[8];
#pragma unroll
            for (int i = 0; i < 4; ++i) { r[2 * i] = bf_lo(rr[i]); r[2 * i + 1] = bf_hi(rr[i]); k[2 * i] = bf_lo(kq[i]); k[2 * i + 1] = bf_hi(kq[i]); a[2 * i] = bf_lo(ic[i]); a[2 * i + 1] = bf_hi(ic[i]); lw[i] = l0[i]; lw[4 + i] = l1[i]; }
            float kk[8], ss = 0.f;
#pragma unroll
            for (int i = 0; i < 8; ++i) { kk[i] = k[i] * kkc[i]; ss += kk[i] * kk[i]; }
            ss = red8(ss);
            const float inv = fminf(__builtin_amdgcn_rsqf(ss), 1e12f);
            float sa = 0.f, kd[8];
#pragma unroll
            for (int i = 0; i < 8; ++i) { kk[i] *= inv; sa += S[i] * kk[i]; kd[i] = k[i] * (1.f + (a[i] - 1.f) * kac[i]); }
            sa = red8(sa);
            float y = 0.f;
#pragma unroll
            for (int i = 0; i < 8; ++i) { S[i] = S[i] * __expf(lw[i]) - sa * (kk[i] * a[i]) + vv * kd[i]; y += S[i] * r[i]; }
            y = red8(y);
            if (ks == 0) yp[m * D + h * 64 + row] = y;
        }
    }
}
#endif

constexpr int LDT = 72, LDF = 68;
constexpr int TILE_B = 64 * LDT * 2, TILE_F = 64 * LDF * 4;
constexpr int L_KK = 0, L_KKT = TILE_B, L_LKT = 2 * TILE_B, L_R = 3 * TILE_B, L_B = 4 * TILE_B, L_K = 5 * TILE_B, L_BH = 6 * TILE_B, L_KH = 7 * TILE_B, L_VT = 8 * TILE_B;
constexpr int L_LBB = 9 * TILE_B, L_ARB = 10 * TILE_B, L_ARK = 11 * TILE_B;
constexpr int LDP = 40;
constexpr int L_RP = 12 * TILE_B, L_DI = L_RP + 128 * LDP * 2, L_GAMC = L_DI + 64 * LDP * 2, L_LAMP = L_GAMC + 256, L_WKV_END = L_LAMP + 2048;
constexpr int L_RT = L_KKT;
constexpr int L_WT = L_B, L_T2T = L_K, L_XT = L_B, L_E = L_KK, L_FF = L_LBB;
static_assert(L_WKV_END <= RING_BYTES, "wkv LDS map");
typedef const LAS bf16_t* lds_bf;
template <bool SWAP>
__device__ __forceinline__ f32x4 tile_mma(lds_bf X, lds_bf Y, int mt, int nt, int fr, int fq) {
    f32x4 acc = (f32x4){0.f, 0.f, 0.f, 0.f};
#pragma unroll
    for (int kk = 0; kk < 2; ++kk) {
        const bf16x8 xa = *(const LAS bf16x8*)(X + (mt * 16 + fr) * LDT + kk * 32 + fq * 8), yb = *(const LAS bf16x8*)(Y + (nt * 16 + fr) * LDT + kk * 32 + fq * 8);
        acc = SWAP ? __builtin_amdgcn_mfma_f32_16x16x32_bf16(yb, xa, acc, 0, 0, 0) : __builtin_amdgcn_mfma_f32_16x16x32_bf16(xa, yb, acc, 0, 0, 0);
    }
    return acc;
}
__device__ __forceinline__ void wkv_diag_inverse(LAS unsigned char* lds, int lane) {
    const int I = lane >> 4, cc = lane & 15;
    lds_bf LB = (lds_bf)(lds + L_LBB) + (16 * I) * LDT + 16 * I;
    float x[16];
#pragma unroll
    for (int r = 0; r < 16; ++r) {
        float acc = (r == cc) ? 1.f : 0.f;
        if (r > 0) { const u32x4 l0 = *(const LAS u32x4*)(LB + r * LDT), l1 = *(const LAS u32x4*)(LB + r * LDT + 8);
#pragma unroll
            for (int j = 0; j < r; ++j) { const unsigned w = j < 8 ? l0[j >> 1] : l1[(j - 8) >> 1]; const float lv = (j & 1) ? bf_hi(w) : bf_lo(w); acc -= lv * x[j]; } }
        x[r] = acc;
        ((LAS bf16_t*)(lds + L_DI))[(16 * I + r) * LDP + cc] = (bf16_t)f2bf(acc);
    }
}
__device__ __forceinline__ void wkv_solve_blocked(LAS unsigned char* lds, int wave, int fr, int fq) {
    lds_bf XT = (lds_bf)(lds + L_XT) + (16 * wave + fr) * LDT, RT = (lds_bf)(lds + L_RT) + (16 * wave + fr) * LDT, LB = (lds_bf)(lds + L_LBB), DI = (lds_bf)(lds + L_DI);
    LAS bf16_t* RP = (LAS bf16_t*)(lds + L_RP) + (16 * wave + fr) * LDP;
#pragma unroll
    for (int I = 0; I < 4; ++I) {
        f32x4 acc = (f32x4){0.f, 0.f, 0.f, 0.f};
#pragma unroll
        for (int kk = 0; kk < (I == 0 ? 0 : (I == 3 ? 2 : 1)); ++kk) {
            const bf16x8 xa = *(const LAS bf16x8*)(XT + kk * 32 + fq * 8), yb = *(const LAS bf16x8*)(LB + (16 * I + fr) * LDT + kk * 32 + fq * 8);
            acc = __builtin_amdgcn_mfma_f32_16x16x32_bf16(yb, xa, acc, 0, 0, 0); }
        const u32x2 rt = *(const LAS u32x2*)(RT + 16 * I + 4 * fq);
        { u32x2 w; w.x = pk2(bf_lo(rt.x) - acc[0], bf_hi(rt.x) - acc[1]); w.y = pk2(bf_lo(rt.y) - acc[2], bf_hi(rt.y) - acc[3]); *(LAS u32x2*)(RP + 4 * fq) = w; }
        asm volatile("s_waitcnt lgkmcnt(0)" ::: "memory");
        const bf16x8 ra = *(const LAS bf16x8*)(RP + fq * 8), db = *(const LAS bf16x8*)(DI + (16 * I + fr) * LDP + fq * 8);
        const f32x4 xi = __builtin_amdgcn_mfma_f32_16x16x32_bf16(db, ra, (f32x4){0.f, 0.f, 0.f, 0.f}, 0, 0, 0);
        { u32x2 w; w.x = pk2(xi[0], xi[1]); w.y = pk2(xi[2], xi[3]); *(LAS u32x2*)((LAS bf16_t*)XT + 16 * I + 4 * fq) = w; }
        asm volatile("s_waitcnt lgkmcnt(0)" ::: "memory");
    }
}
__device__ __forceinline__ void phase_wkv_prep(const Frame& F, const bf16_t* R, const bf16_t* Kx, const bf16_t* V, const bf16_t* LOGW, const bf16_t* ICLR,
                                               const float* kkw, const float* kaw, const float* rkw, bf16_t* CP, bf16_t* CQ, bf16_t* CG, bf16_t* Y, float* BONUS, const int dbg) {
    LAS unsigned char* lds = F.lds; const int wave = F.wave;
#define OPAQUE_LANE int lane = F.lane; asm volatile("" : "+v"(lane)); const int fr = lane & 15, fq = lane >> 4; (void)fr; (void)fq
    unsigned short in_r[8], in_k[8], in_v[8], in_a[8], in_w[8];
#define WKV_LOAD_INPUTS(item_) do { const int chain_ = (item_) >> 6, ck_ = (item_) & 63, dir_ = chain_ >> 6, bh_ = chain_ & 63, b_ = bh_ >> 4, h_ = bh_ & 15; const int c_ = F.lane; \
        _Pragma("unroll") for (int i = 0; i < 8; ++i) { const int pos_ = ck_ * 64 + wave * 8 + i, t_ = dir_ ? SEQ - 1 - pos_ : pos_; const size_t off_ = ((size_t)b_ * SEQ + t_) * D + h_ * 64 + c_; \
            in_r[i] = R[off_]; in_k[i] = Kx[off_]; in_v[i] = V[off_]; in_a[i] = ICLR[(size_t)dir_ * T * D + off_]; in_w[i] = LOGW[(size_t)dir_ * T * D + off_]; } } while (0)
    for (int u = F.tid; u < (128 * LDP * 2 + 64 * LDP * 2) / 4; u += NTHREADS) ((LAS unsigned*)(lds + L_RP))[u] = 0u;
    if ((int)blockIdx.x < 8192) WKV_LOAD_INPUTS((int)blockIdx.x);
    for (int item = blockIdx.x; item < 8192; item += F.G) {
        const int chain = item >> 6, ck = item & 63, dir = chain >> 6, bh = chain & 63, b = bh >> 4, h = bh & 15;
        if (!(dbg & 1)) {
            OPAQUE_LANE; const int c = lane; const float kkc = kkw[h * 64 + c], kac = kaw[h * 64 + c], rkc = rkw[h * 64 + c];
            float r[8], kk[8], bb[8], kd[8], vv[8], lam[8], kx[8], ax[8], lwx[8]; float run = 0.f; size_t tok[8];
#pragma unroll
            for (int i = 0; i < 8; ++i) {
                const int p = wave * 8 + i, pos = ck * 64 + p, t = dir ? SEQ - 1 - pos : pos; tok[i] = (size_t)b * SEQ + t;
                r[i] = __uint_as_float((unsigned)in_r[i] << 16); kx[i] = __uint_as_float((unsigned)in_k[i] << 16); vv[i] = __uint_as_float((unsigned)in_v[i] << 16); ax[i] = __uint_as_float((unsigned)in_a[i] << 16); lwx[i] = __uint_as_float((unsigned)in_w[i] << 16); }
            float red[16];
#pragma unroll
            for (int i = 0; i < 8; ++i) { const float kr = kx[i] * kkc; kd[i] = kx[i] * (1.f + (ax[i] - 1.f) * kac); red[i] = kr * kr; red[8 + i] = r[i] * kd[i] * rkc; }
            const float tot = reduce_scatter16(red, lane);
#pragma unroll
            for (int i = 0; i < 8; ++i) {
                const float ss = __shfl(tot, ((i >> 2) & 1) * 16 + ((i >> 1) & 1) * 8 + (i & 1) * 4);
                const float inv = fminf(__builtin_amdgcn_rsqf(ss), 1e12f);
                kk[i] = kx[i] * kkc * inv; bb[i] = kk[i] * ax[i];
                run += lwx[i]; lam[i] = run; }
            if ((lane & 35) == 32) { const int i = ((lane >> 4) & 1) * 4 + ((lane >> 3) & 1) * 2 + ((lane >> 2) & 1); BONUS[((size_t)dir * T + tok[0] + (dir ? -i : i)) * RH + h] = tot; }
            LAS float* LAMP = (LAS float*)(lds + L_LAMP);
            LAMP[wave * 64 + c] = run;
            LDS_BARRIER();
            float offs = 0.f, lamC = 0.f;
#pragma unroll
            for (int w = 0; w < NWAVES; ++w) { const float x = LAMP[w * 64 + c]; lamC += x; offs += (w < wave) ? x : 0.f; }
            if (wave == 0) ((LAS float*)(lds + L_GAMC))[c] = __expf(lamC);
            float bh8[8], kh8[8], kt8[8]; const float expC = __expf(lamC); float eprev = __expf(offs);
#pragma unroll
            for (int i = 0; i < 8; ++i) {
                const int p = wave * 8 + i; const float lp = offs + lam[i];
                const float ep = __expf(lp), em = __builtin_amdgcn_rcpf(ep), ec = expC * em;
                kt8[i] = kk[i] * eprev; ((LAS bf16_t*)(lds + L_KK))[p * LDT + c] = (bf16_t)f2bf(kt8[i]);
                ((LAS bf16_t*)(lds + L_R))[p * LDT + c] = (bf16_t)f2bf(r[i] * ep);
                ((LAS bf16_t*)(lds + L_B))[p * LDT + c] = (bf16_t)f2bf(bb[i] * em);
                ((LAS bf16_t*)(lds + L_K))[p * LDT + c] = (bf16_t)f2bf(kd[i] * em);
                bh8[i] = bb[i] * ec; kh8[i] = kd[i] * ec; eprev = ep;
            }
            u32x4 w; w.x = pk2(bh8[0], bh8[1]); w.y = pk2(bh8[2], bh8[3]); w.z = pk2(bh8[4], bh8[5]); w.w = pk2(bh8[6], bh8[7]); *(LAS u32x4*)((LAS bf16_t*)(lds + L_BH) + c * LDT + wave * 8) = w;
            w.x = pk2(kh8[0], kh8[1]); w.y = pk2(kh8[2], kh8[3]); w.z = pk2(kh8[4], kh8[5]); w.w = pk2(kh8[6], kh8[7]); *(LAS u32x4*)((LAS bf16_t*)(lds + L_KH) + c * LDT + wave * 8) = w;
            w.x = pk2(vv[0], vv[1]); w.y = pk2(vv[2], vv[3]); w.z = pk2(vv[4], vv[5]); w.w = pk2(vv[6], vv[7]); *(LAS u32x4*)((LAS bf16_t*)(lds + L_VT) + c * LDT + wave * 8) = w;
            w.x = pk2(kt8[0], kt8[1]); w.y = pk2(kt8[2], kt8[3]); w.z = pk2(kt8[4], kt8[5]); w.w = pk2(kt8[6], kt8[7]); *(LAS u32x4*)((LAS bf16_t*)(lds + L_KKT) + c * LDT + wave * 8) = w;
        }
        LDS_BARRIER();
        if (!(dbg & 2)) {
            OPAQUE_LANE; const int q = wave >> 1; lds_bf X = (lds_bf)(lds + ((q & 2) ? L_R : L_KK)), Yb = (lds_bf)(lds + ((q & 1) ? L_K : L_B));
            f32x4 acc[2][4];
            if (q == 1) {
#pragma unroll
                for (int mi = 0; mi < 2; ++mi)
#pragma unroll
                    for (int nt = 0; nt < 4; ++nt) acc[mi][nt] = tile_mma<false>(X, Yb, 2 * (wave & 1) + mi, nt, fr, fq);
#pragma unroll
                for (int mi = 0; mi < 2; ++mi)
#pragma unroll
                    for (int nt = 0; nt < 4; ++nt) { const int mt = 2 * (wave & 1) + mi;
                        f32x4 a = acc[mi][nt]; const int t0 = mt * 16 + 4 * fq, jc = nt * 16 + fr;
#pragma unroll
                        for (int jj = 0; jj < 4; ++jj) a[jj] = (jc < t0 + jj) ? a[jj] : 0.f;
                        u32x2 w; w.x = pk2(a[0], a[1]); w.y = pk2(a[2], a[3]); *(LAS u32x2*)((LAS bf16_t*)(lds + L_LKT) + jc * LDT + t0) = w; }
            } else {
#pragma unroll
                for (int mi = 0; mi < 2; ++mi)
#pragma unroll
                    for (int nt = 0; nt < 4; ++nt) acc[mi][nt] = tile_mma<true>(X, Yb, 2 * (wave & 1) + mi, nt, fr, fq);
#pragma unroll
                for (int mi = 0; mi < 2; ++mi)
#pragma unroll
                    for (int nt = 0; nt < 4; ++nt) { const int mt = 2 * (wave & 1) + mi; f32x4 a = acc[mi][nt]; const int row = mt * 16 + fr, col = nt * 16 + 4 * fq;
#pragma unroll
                        for (int jj = 0; jj < 4; ++jj) { const bool keep = (q & 2) ? (col + jj <= row) : (col + jj < row); a[jj] = keep ? a[jj] : 0.f; }
                        u32x2 w; w.x = pk2(a[0], a[1]); w.y = pk2(a[2], a[3]);
                        *(LAS u32x2*)((LAS bf16_t*)(lds + (q == 0 ? L_LBB : (q == 2 ? L_ARB : L_ARK))) + row * LDT + col) = w; }
            }
        }
        LDS_BARRIER();
        if (!(dbg & 4)) { OPAQUE_LANE;
            for (int u = F.tid; u < 2 * TILE_B / 4; u += NTHREADS) ((LAS unsigned*)(lds + L_XT))[u] = 0u;
            if (wave == 0) wkv_diag_inverse(lds, lane);
            LDS_BARRIER();
            wkv_solve_blocked(lds, wave, fr, fq); }
        LDS_BARRIER();
        if (item + F.G < 8192) WKV_LOAD_INPUTS(item + F.G);
        if (!(dbg & 8)) {
            OPAQUE_LANE; const int q = wave >> 1; lds_bf X = (lds_bf)(lds + ((q & 2) ? L_ARB : L_BH)), Yb = (lds_bf)(lds + ((q & 1) ? L_T2T : L_WT));
            bf16_t* gout = ((q & 2) ? CQ : CP) + (size_t)item * 4096;
            f32x4 acc[2][4];
#pragma unroll
            for (int mi = 0; mi < 2; ++mi)
#pragma unroll
                for (int nt = 0; nt < 4; ++nt) acc[mi][nt] = tile_mma<true>(X, Yb, 2 * (wave & 1) + mi, nt, fr, fq);
#pragma unroll
            for (int mi = 0; mi < 2; ++mi)
#pragma unroll
                for (int nt = 0; nt < 4; ++nt) { const int mt = 2 * (wave & 1) + mi; const f32x4 a = acc[mi][nt];
                    const int row = mt * 16 + fr, col = nt * 16 + 4 * fq; f32x4 o;
                    if (q == 0) { const float g = ((const LAS float*)(lds + L_GAMC))[row];
#pragma unroll
                        for (int jj = 0; jj < 4; ++jj) o[jj] = ((col + jj == row) ? g : 0.f) - a[jj]; }
                    else if (q == 1) { const u32x2 kh = *(const LAS u32x2*)((lds_bf)(lds + L_KH) + row * LDT + col); o[0] = bf_lo(kh.x) - a[0]; o[1] = bf_hi(kh.x) - a[1]; o[2] = bf_lo(kh.y) - a[2]; o[3] = bf_hi(kh.y) - a[3]; }
                    else if (q == 2) { const u32x2 rr = *(const LAS u32x2*)((lds_bf)(lds + L_R) + row * LDT + col); o[0] = bf_lo(rr.x) - a[0]; o[1] = bf_hi(rr.x) - a[1]; o[2] = bf_lo(rr.y) - a[2]; o[3] = bf_hi(rr.y) - a[3]; }
                    else { const u32x2 ak = *(const LAS u32x2*)((lds_bf)(lds + L_ARK) + row * LDT + col); o[0] = bf_lo(ak.x) - a[0]; o[1] = bf_hi(ak.x) - a[1]; o[2] = bf_lo(ak.y) - a[2]; o[3] = bf_hi(ak.y) - a[3]; }
                    u32x2 w; w.x = pk2(o[0], o[1]); w.y = pk2(o[2], o[3]);
                    if (q == 0 || q == 2) *(u32x2*)(gout + row * 64 + col) = w;
                    else *(LAS u32x2*)((LAS bf16_t*)(lds + (q == 1 ? L_E : L_FF)) + row * LDT + col) = w; }
        }
        LDS_BARRIER();
        if (!(dbg & 16)) {
            OPAQUE_LANE; lds_bf VT = (lds_bf)(lds + L_VT);
            if (wave < 4) {
#pragma unroll
                for (int nt = 0; nt < 4; ++nt) { const f32x4 a = tile_mma<false>((lds_bf)(lds + L_E), VT, wave, nt, fr, fq);
                    u32x2 w; w.x = pk2(a[0], a[1]); w.y = pk2(a[2], a[3]); *(u32x2*)(CG + (size_t)item * 4096 + (nt * 16 + fr) * 64 + wave * 16 + 4 * fq) = w; }
            } else {
                const int mt = wave - 4; const int p = mt * 16 + fr, pos = ck * 64 + p, t = dir ? SEQ - 1 - pos : pos;
                bf16_t* yrow = Y + (size_t)dir * T * D + ((size_t)b * SEQ + t) * D + h * 64;
#pragma unroll
                for (int nt = 0; nt < 4; ++nt) { const f32x4 a = tile_mma<true>((lds_bf)(lds + L_FF), VT, mt, nt, fr, fq); u32x2 w; w.x = pk2(a[0], a[1]); w.y = pk2(a[2], a[3]); *(u32x2*)(yrow + nt * 16 + 4 * fq) = w; }
            }
        }
        LDS_BARRIER();
    }
}

constexpr int P2_SLOT = 8192, P2_HALF = 9 * P2_SLOT + 4096;
constexpr int Q_KK = 0, Q_R = P2_SLOT, Q_B = 2 * P2_SLOT, Q_K = 3 * P2_SLOT, Q_KKT = 4 * P2_SLOT, Q_LKT = 5 * P2_SLOT, Q_LBB = 6 * P2_SLOT, Q_ARB = 7 * P2_SLOT, Q_ARK = 8 * P2_SLOT, Q_MISC = 9 * P2_SLOT;
constexpr int Q_RP = Q_KK, Q_DI = Q_R, Q_XT = Q_B, Q_RT = Q_KKT, Q_BH = Q_KKT, Q_KH = Q_LKT, Q_VT = Q_LBB, Q_E = Q_LKT, Q_F = Q_ARK, Q_GAMC = Q_MISC, Q_LAMP = Q_MISC + 256;
static_assert(2 * P2_HALF <= LDSCTL_OFF, "two prep halves must fit below the LDS control words");
__device__ __forceinline__ int TIX(int r, int c) { return r * 64 + (c ^ ((r & 7) << 3)); }
template <bool SWAP>
__device__ __forceinline__ f32x4 tile_mma2(lds_bf X, lds_bf Y, int mt, int nt, int fr, int fq) {
    f32x4 acc = (f32x4){0.f, 0.f, 0.f, 0.f};
#pragma unroll
    for (int kk = 0; kk < 2; ++kk) {
        const bf16x8 xa = *(const LAS bf16x8*)(X + TIX(mt * 16 + fr, kk * 32 + fq * 8)), yb = *(const LAS bf16x8*)(Y + TIX(nt * 16 + fr, kk * 32 + fq * 8));
        acc = SWAP ? __builtin_amdgcn_mfma_f32_16x16x32_bf16(yb, xa, acc, 0, 0, 0) : __builtin_amdgcn_mfma_f32_16x16x32_bf16(xa, yb, acc, 0, 0, 0);
    }
    return acc;
}
__device__ __forceinline__ void phase_wkv_prep2(const Frame& F, const bf16_t* R, const bf16_t* Kx, const bf16_t* V, const bf16_t* LOGW, const bf16_t* ICLR,
                                                const float* kkw, const float* kaw, const float* rkw, bf16_t* CP, bf16_t* CQ, bf16_t* CG, bf16_t* Y, float* BONUS) {
    const int wave = F.wave, hb = wave >> 2, w4 = wave & 3;
    LAS unsigned char* lds = F.lds + hb * P2_HALF;
    volatile LAS unsigned* hcnt = (volatile LAS unsigned*)(lds + Q_MISC + 2048); unsigned hgen = 0u;
    if (w4 == 0 && F.lane == 0) *hcnt = 0u;
    __syncthreads();
#define HALF_BARRIER() do { asm volatile("s_waitcnt lgkmcnt(0)" ::: "memory"); if (F.lane == 0) __hip_atomic_fetch_add((LAS unsigned*)hcnt, 1u, __ATOMIC_RELAXED, __HIP_MEMORY_SCOPE_WORKGROUP); hgen += 4u; \
        while ((unsigned)__builtin_amdgcn_readfirstlane((int)*hcnt) < hgen) __builtin_amdgcn_s_sleep(1); asm volatile("" ::: "memory"); } while (0)
#define OPQ_LANE int lane = F.lane; asm volatile("" : "+v"(lane)); const int fr = lane & 15, fq = lane >> 4; (void)fr; (void)fq
    for (int pi = blockIdx.x; pi < 4096; pi += F.G) {
        const int item = 2 * pi + hb, chain = item >> 6, ck = item & 63, dir = chain >> 6, bh = chain & 63, b = bh >> 4, h = bh & 15;
        unsigned rrp[8], bhp[8], khp[8], vtp[8];
        {
            OPQ_LANE; const int c = lane; const float kkc = kkw[h * 64 + c], kac = kaw[h * 64 + c], rkc = rkw[h * 64 + c];
            float r[16], kx[16], vv[16], ax[16], lam[16], kd[16]; float run = 0.f;
            const int pos0 = ck * 64 + 16 * w4; const size_t tok0 = (size_t)b * SEQ + (dir ? SEQ - 1 - pos0 : pos0);
            const unsigned base32 = ((unsigned)tok0 * D + h * 64 + c) * 2u;
            const char* pR = (const char*)R; const char* pK = (const char*)Kx; const char* pV = (const char*)V; const char* pA = (const char*)(ICLR + (size_t)dir * T * D); const char* pW = (const char*)(LOGW + (size_t)dir * T * D);
#pragma unroll
            for (int i = 0; i < 16; ++i) { const unsigned o = dir ? base32 - (unsigned)i * (D * 2u) : base32 + (unsigned)i * (D * 2u);
                r[i] = bf1((const bf16_t*)(pR + o)); kx[i] = bf1((const bf16_t*)(pK + o)); vv[i] = bf1((const bf16_t*)(pV + o)); ax[i] = bf1((const bf16_t*)(pA + o)); lam[i] = bf1((const bf16_t*)(pW + o)); }
            float red1[16], red2[16];
#pragma unroll
            for (int i = 0; i < 16; ++i) { const float kr = kx[i] * kkc; kd[i] = kx[i] * (1.f + (ax[i] - 1.f) * kac); red1[i] = kr * kr; red2[i] = r[i] * kd[i] * rkc; }
            const float tot1 = reduce_scatter16(red1, lane), tot2 = reduce_scatter16(red2, lane);
            if ((lane & 3) == 0) { const int i = rs16_index(lane); BONUS[((size_t)dir * T + tok0 + (dir ? -i : i)) * RH + h] = tot2; }
            float kk[16], bb[16];
#pragma unroll
            for (int i = 0; i < 16; ++i) { const float ss = __shfl(tot1, ((i >> 3) & 1) * 32 + ((i >> 2) & 1) * 16 + ((i >> 1) & 1) * 8 + (i & 1) * 4);
                const float inv = fminf(__builtin_amdgcn_rsqf(ss), 1e12f);   kk[i] = kx[i] * kkc * inv; bb[i] = kk[i] * ax[i]; run += lam[i]; lam[i] = run; }
            LAS float* LAMP = (LAS float*)(lds + Q_LAMP);
            LAMP[w4 * 64 + c] = run;
            HALF_BARRIER();
            float offs = 0.f, lamC = 0.f;
#pragma unroll
            for (int w = 0; w < 4; ++w) { const float x = LAMP[w * 64 + c]; lamC += x; offs += (w < w4) ? x : 0.f; }
            const float expC = __expf(lamC); float eprev = __expf(offs);
            if (w4 == 0) ((LAS float*)(lds + Q_GAMC))[c] = expC;
            float kt[16], rr[16], bhv[16], khv[16];
#pragma unroll
            for (int i = 0; i < 16; ++i) { const int p = 16 * w4 + i; const float ep = __expf(offs + lam[i]), em = __builtin_amdgcn_rcpf(ep), ec = expC * em;
                kt[i] = kk[i] * eprev; rr[i] = r[i] * ep; bhv[i] = bb[i] * ec; khv[i] = kd[i] * ec; eprev = ep;
                ((LAS bf16_t*)(lds + Q_KK))[TIX(p, c)] = (bf16_t)f2bf(kt[i]); ((LAS bf16_t*)(lds + Q_R))[TIX(p, c)] = (bf16_t)f2bf(rr[i]);
                ((LAS bf16_t*)(lds + Q_B))[TIX(p, c)] = (bf16_t)f2bf(bb[i] * em); ((LAS bf16_t*)(lds + Q_K))[TIX(p, c)] = (bf16_t)f2bf(kd[i] * em); }
#pragma unroll
            for (int q = 0; q < 8; ++q) { rrp[q] = pk2(rr[2 * q], rr[2 * q + 1]); bhp[q] = pk2(bhv[2 * q], bhv[2 * q + 1]); khp[q] = pk2(khv[2 * q], khv[2 * q + 1]); vtp[q] = pk2(vv[2 * q], vv[2 * q + 1]); }
#pragma unroll
            for (int q = 0; q < 2; ++q) { u32x4 w; w.x = pk2(kt[8 * q], kt[8 * q + 1]); w.y = pk2(kt[8 * q + 2], kt[8 * q + 3]); w.z = pk2(kt[8 * q + 4], kt[8 * q + 5]); w.w = pk2(kt[8 * q + 6], kt[8 * q + 7]);
                *(LAS u32x4*)((LAS bf16_t*)(lds + Q_KKT) + TIX(c, 16 * w4 + 8 * q)) = w; }
        }
        HALF_BARRIER();
        {
            OPQ_LANE; const int q = w4; lds_bf X = (lds_bf)(lds + ((q & 2) ? Q_R : Q_KK)), Yb = (lds_bf)(lds + ((q & 1) ? Q_K : Q_B));
            f32x4 acc[4][4];
            if (q == 1) {
#pragma unroll
                for (int mt = 0; mt < 4; ++mt)
#pragma unroll
                    for (int nt = 0; nt <= mt; ++nt) acc[mt][nt] = tile_mma2<false>(X, Yb, mt, nt, fr, fq);
#pragma unroll
                for (int mt = 0; mt < 4; ++mt)
#pragma unroll
                    for (int nt = 0; nt < 4; ++nt) { const int t0 = mt * 16 + 4 * fq, jc = nt * 16 + fr; u32x2 w = (u32x2){0u, 0u};
                        if (nt <= mt) { f32x4 a = acc[mt][nt];
                            if (nt == mt) {
#pragma unroll
                                for (int jj = 0; jj < 4; ++jj) a[jj] = (jc < t0 + jj) ? a[jj] : 0.f; }
                            w.x = pk2(a[0], a[1]); w.y = pk2(a[2], a[3]); }
                        *(LAS u32x2*)((LAS bf16_t*)(lds + Q_LKT) + TIX(jc, t0)) = w; }
            } else {
#pragma unroll
                for (int mt = 0; mt < 4; ++mt)
#pragma unroll
                    for (int nt = 0; nt <= mt; ++nt) acc[mt][nt] = tile_mma2<true>(X, Yb, mt, nt, fr, fq);
#pragma unroll
                for (int mt = 0; mt < 4; ++mt)
#pragma unroll
                    for (int nt = 0; nt < 4; ++nt) { const int row = mt * 16 + fr, col = nt * 16 + 4 * fq; u32x2 w = (u32x2){0u, 0u};
                        if (nt <= mt) { f32x4 a = acc[mt][nt];
                            if (nt == mt) {
#pragma unroll
                                for (int jj = 0; jj < 4; ++jj) { const bool keep = (q & 2) ? (col + jj <= row) : (col + jj < row); a[jj] = keep ? a[jj] : 0.f; } }
                            w.x = pk2(a[0], a[1]); w.y = pk2(a[2], a[3]); }
                        *(LAS u32x2*)((LAS bf16_t*)(lds + (q == 0 ? Q_LBB : (q == 2 ? Q_ARB : Q_ARK))) + TIX(row, col)) = w; }
            }
        }
        HALF_BARRIER();
        {
            OPQ_LANE;
            if (w4 == 0) {
                const int I = lane >> 4, cc = lane & 15; lds_bf LB = (lds_bf)(lds + Q_LBB); float x[16];
#pragma unroll
                for (int r = 0; r < 16; ++r) {
                    float acc = (r == cc) ? 1.f : 0.f;
                    if (r > 0) { const u32x4 l0 = *(const LAS u32x4*)(LB + TIX(16 * I + r, 16 * I)), l1 = *(const LAS u32x4*)(LB + TIX(16 * I + r, 16 * I + 8));
#pragma unroll
                        for (int j = 0; j < r; ++j) { const unsigned w = j < 8 ? l0[j >> 1] : l1[(j - 8) >> 1]; const float lv = (j & 1) ? bf_hi(w) : bf_lo(w); acc -= lv * x[j]; } }
                    x[r] = acc;
                    ((LAS bf16_t*)(lds + Q_DI))[(16 * I + r) * 32 + cc] = (bf16_t)f2bf(acc);
                }
            } else {
                const int t3 = (w4 - 1) * 64 + lane;
                for (int u = t3; u < 2 * P2_SLOT / 16; u += 192) ((LAS u32x4*)(lds + Q_XT))[u] = (u32x4){0u, 0u, 0u, 0u};
                if (t3 < 128) { const int row = t3 >> 1, hf = t3 & 1; *(LAS u32x4*)((LAS bf16_t*)(lds + Q_DI) + row * 32 + 16 + hf * 8) = (u32x4){0u, 0u, 0u, 0u}; }
            }
        }
        HALF_BARRIER();
        {
            OPQ_LANE; lds_bf LB = (lds_bf)(lds + Q_LBB), DI = (lds_bf)(lds + Q_DI);
#pragma unroll
            for (int I = 0; I < 4; ++I) {
                f32x4 acc[2];
#pragma unroll
                for (int u = 0; u < 2; ++u) { const int col = 16 * (w4 + 4 * u) + fr; acc[u] = (f32x4){0.f, 0.f, 0.f, 0.f};
#pragma unroll
                    for (int kk = 0; kk < (I == 0 ? 0 : (I == 3 ? 2 : 1)); ++kk) {
                        const bf16x8 xa = *(const LAS bf16x8*)((lds_bf)(lds + Q_XT) + TIX(col, kk * 32 + fq * 8)), yb = *(const LAS bf16x8*)(LB + TIX(16 * I + fr, kk * 32 + fq * 8));
                        acc[u] = __builtin_amdgcn_mfma_f32_16x16x32_bf16(yb, xa, acc[u], 0, 0, 0); } }
#pragma unroll
                for (int u = 0; u < 2; ++u) { const int col = 16 * (w4 + 4 * u) + fr; const u32x2 rt = *(const LAS u32x2*)((lds_bf)(lds + Q_RT) + TIX(col, 16 * I + 4 * fq));
                    u32x2 w; w.x = pk2(bf_lo(rt.x) - acc[u][0], bf_hi(rt.x) - acc[u][1]); w.y = pk2(bf_lo(rt.y) - acc[u][2], bf_hi(rt.y) - acc[u][3]);
                    *(LAS u32x2*)((LAS bf16_t*)(lds + Q_RP) + col * 32 + 4 * fq) = w; }
                asm volatile("s_waitcnt lgkmcnt(0)" ::: "memory");
                f32x4 xi[2];
#pragma unroll
                for (int u = 0; u < 2; ++u) { const int col = 16 * (w4 + 4 * u) + fr; const bf16x8 ra = *(const LAS bf16x8*)((lds_bf)(lds + Q_RP) + col * 32 + fq * 8), db = *(const LAS bf16x8*)(DI + (16 * I + fr) * 32 + fq * 8);
                    xi[u] = __builtin_amdgcn_mfma_f32_16x16x32_bf16(db, ra, (f32x4){0.f, 0.f, 0.f, 0.f}, 0, 0, 0); }
#pragma unroll
                for (int u = 0; u < 2; ++u) { const int col = 16 * (w4 + 4 * u) + fr; u32x2 w; w.x = pk2(xi[u][0], xi[u][1]); w.y = pk2(xi[u][2], xi[u][3]); *(LAS u32x2*)((LAS bf16_t*)(lds + Q_XT) + TIX(col, 16 * I + 4 * fq)) = w; }
                asm volatile("s_waitcnt lgkmcnt(0)" ::: "memory");
            }
        }
        HALF_BARRIER();
        {
            OPQ_LANE; const int c = lane;
#pragma unroll
            for (int q = 0; q < 8; ++q) { ((LAS bf16_t*)(lds + Q_R))[TIX(16 * w4 + 2 * q, c)] = (bf16_t)(rrp[q] & 0xffffu); ((LAS bf16_t*)(lds + Q_R))[TIX(16 * w4 + 2 * q + 1, c)] = (bf16_t)(rrp[q] >> 16); }
#pragma unroll
            for (int q = 0; q < 2; ++q) {
                *(LAS u32x4*)((LAS bf16_t*)(lds + Q_BH) + TIX(c, 16 * w4 + 8 * q)) = (u32x4){bhp[4 * q], bhp[4 * q + 1], bhp[4 * q + 2], bhp[4 * q + 3]};
                *(LAS u32x4*)((LAS bf16_t*)(lds + Q_KH) + TIX(c, 16 * w4 + 8 * q)) = (u32x4){khp[4 * q], khp[4 * q + 1], khp[4 * q + 2], khp[4 * q + 3]};
                *(LAS u32x4*)((LAS bf16_t*)(lds + Q_VT) + TIX(c, 16 * w4 + 8 * q)) = (u32x4){vtp[4 * q], vtp[4 * q + 1], vtp[4 * q + 2], vtp[4 * q + 3]}; }
        }
        HALF_BARRIER();
        {
            OPQ_LANE; const int q = w4; lds_bf X = (lds_bf)(lds + ((q & 2) ? Q_ARB : Q_BH)), Yb = (lds_bf)(lds + Q_XT) + ((q & 1) ? 64 * 64 : 0);
            bf16_t* gout = ((q & 2) ? CQ : CP) + (size_t)item * 4096;
            f32x4 acc[4][4];
#pragma unroll
            for (int mt = 0; mt < 4; ++mt)
#pragma unroll
                for (int nt = 0; nt < 4; ++nt) acc[mt][nt] = tile_mma2<true>(X, Yb, mt, nt, fr, fq);
#pragma unroll
            for (int mt = 0; mt < 4; ++mt)
#pragma unroll
                for (int nt = 0; nt < 4; ++nt) { const f32x4 a = acc[mt][nt]; const int row = mt * 16 + fr, col = nt * 16 + 4 * fq; f32x4 o;
                    if (q == 0) { const float g = ((const LAS float*)(lds + Q_GAMC))[row];
#pragma unroll
                        for (int jj = 0; jj < 4; ++jj) o[jj] = ((col + jj == row) ? g : 0.f) - a[jj]; }
                    else { const u32x2 src = *(const LAS u32x2*)((lds_bf)(lds + (q == 1 ? Q_KH : (q == 2 ? Q_R : Q_ARK))) + TIX(row, col));
                        o[0] = bf_lo(src.x) - a[0]; o[1] = bf_hi(src.x) - a[1]; o[2] = bf_lo(src.y) - a[2]; o[3] = bf_hi(src.y) - a[3]; }
                    u32x2 w; w.x = pk2(o[0], o[1]); w.y = pk2(o[2], o[3]);
                    if (q == 0 || q == 2) *(u32x2*)(gout + row * 64 + col) = w;
                    else *(LAS u32x2*)((LAS bf16_t*)(lds + (q == 1 ? Q_E : Q_F)) + TIX(row, col)) = w; }
        }
        HALF_BARRIER();
        {
            OPQ_LANE; lds_bf VT = (lds_bf)(lds + Q_VT);
            if (w4 < 2) {
#pragma unroll
                for (int mi = 0; mi < 2; ++mi)
#pragma unroll
                    for (int nt = 0; nt < 4; ++nt) { const int mt = 2 * w4 + mi; const f32x4 a = tile_mma2<false>((lds_bf)(lds + Q_E), VT, mt, nt, fr, fq);
                        u32x2 w; w.x = pk2(a[0], a[1]); w.y = pk2(a[2], a[3]); *(u32x2*)(CG + (size_t)item * 4096 + (nt * 16 + fr) * 64 + mt * 16 + 4 * fq) = w; }
            } else {
#pragma unroll
                for (int mi = 0; mi < 2; ++mi) { const int mt = 2 * (w4 - 2) + mi; const int p = mt * 16 + fr;
                    bf16_t* yrow = Y + (((size_t)chain * 64 + ck) * 64 + p) * 64;
#pragma unroll
                    for (int nt = 0; nt < 4; ++nt) { const f32x4 a = tile_mma2<true>((lds_bf)(lds + Q_F), VT, mt, nt, fr, fq); u32x2 w; w.x = pk2(a[0], a[1]); w.y = pk2(a[2], a[3]); *(u32x2*)(yrow + nt * 16 + 4 * fq) = w; } }
            }
        }
        HALF_BARRIER();
    }
#undef OPQ_LANE
#undef HALF_BARRIER
    __syncthreads();
}
__device__ __forceinline__ void phase_wkv_scan(const Frame& F, const bf16_t* CP, const bf16_t* CQ, const bf16_t* CG, bf16_t* Y) {
    LAS unsigned char* lds = F.lds; const int lane = F.lane, wave = F.wave, fr = lane & 15, fq = lane >> 4;
    LAS bf16_t* SL = (LAS bf16_t*)lds;
    constexpr int SLOT0 = 16384, SLOTB = 24576, OQ = 8192, OG = 16384, OY = 20480;
    for (int item = blockIdx.x; item < 256; item += F.G) {
        const int vh = (item >> 3) & 1, chain = ((item >> 4) << 3) + (item & 7);
        const int vt = wave >> 2, ct = wave & 3;
        const int tt = wave >> 1, vt2 = wave & 1;
        const int dr = wave * 8 + (lane >> 3), dj = (lane & 7) ^ (dr & 7);
        const unsigned offPQ = (unsigned)(dr * 128 + dj * 16);
        const int gr = (wave & 3) * 8 + (lane >> 3);
        const unsigned off3 = wave < 4 ? (unsigned)((vh * 32 + gr) * 128 + (((lane & 7) ^ (gr & 7)) * 16)) : (unsigned)((((wave & 3) * 16 + (lane >> 2)) * 128) + vh * 64 + (lane & 3) * 16);
        const bf16_t* src3 = wave < 4 ? CG : (const bf16_t*)Y;
        const unsigned lds3 = wave < 4 ? (unsigned)(OG + wave * 1024) : (unsigned)(OY + (wave & 3) * 1024);
#define WKV_STAGE(ck_) do { const size_t it_ = ((size_t)chain * 64 + (ck_)) * 8192; const unsigned sb_ = SLOT0 + ((ck_) & 3) * SLOTB; \
            __builtin_amdgcn_global_load_lds((const unsigned*)((const char*)CP + it_ + offPQ), (LAS unsigned*)(lds + sb_ + wave * 1024), 16, 0, 0); \
            __builtin_amdgcn_global_load_lds((const unsigned*)((const char*)CQ + it_ + offPQ), (LAS unsigned*)(lds + sb_ + OQ + wave * 1024), 16, 0, 0); \
            __builtin_amdgcn_global_load_lds((const unsigned*)((const char*)src3 + it_ + off3), (LAS unsigned*)(lds + sb_ + lds3), 16, 0, 0); } while (0)
#define WKV_VMW(n) asm volatile("s_waitcnt vmcnt(" #n ")" ::: "memory")
        for (int u = F.tid; u < 32 * LDT / 2; u += NTHREADS) ((LAS unsigned*)SL)[u] = 0u;
        WKV_STAGE(0); WKV_STAGE(1); WKV_STAGE(2);
        WKV_VMW(6); LDS_BARRIER();
        const int sw = fr & 7;
        const unsigned aP0 = (unsigned)((ct * 16 + fr) * 128 + ((fq ^ sw) * 16)), aP1 = (unsigned)((ct * 16 + fr) * 128 + (((4 + fq) ^ sw) * 16));
        const unsigned aQ0 = (unsigned)(OQ + (tt * 16 + fr) * 128 + ((fq ^ sw) * 16)), aQ1 = (unsigned)(OQ + (tt * 16 + fr) * 128 + (((4 + fq) ^ sw) * 16));
        const unsigned aG = (unsigned)(OG + (vt * 16 + fr) * 128 + (((ct * 2 + (fq >> 1)) ^ sw) * 16) + (fq & 1) * 8);
        const unsigned aY = (unsigned)(OY + (tt * 16 + fr) * 64 + vt2 * 32 + fq * 8);
        bf16_t* ybase = Y + ((size_t)chain * 64 * 64 + tt * 16 + fr) * 64 + vh * 32 + vt2 * 16 + 4 * fq;
        for (int ck0 = 0; ck0 < 64; ck0 += 4) {
#pragma unroll
            for (int u = 0; u < 4; ++u) {
                const int ck = ck0 + u;
                if (ck + 3 < 64) WKV_STAGE(ck + 3);
                LAS unsigned char* sb = lds + SLOT0 + u * SLOTB;
                const u32x2 gg = *(const LAS u32x2*)(sb + aG), yy = *(const LAS u32x2*)(sb + aY);
                const bf16x8 p0 = *(const LAS bf16x8*)(sb + aP0), p1 = *(const LAS bf16x8*)(sb + aP1), q0 = *(const LAS bf16x8*)(sb + aQ0), q1 = *(const LAS bf16x8*)(sb + aQ1);
                f32x4 sacc = (f32x4){bf_lo(gg.x), bf_hi(gg.x), bf_lo(gg.y), bf_hi(gg.y)}, yacc = (f32x4){bf_lo(yy.x), bf_hi(yy.x), bf_lo(yy.y), bf_hi(yy.y)};
                const LAS bf16_t* S0 = SL + (u & 1) * (32 * LDT); LAS bf16_t* S1 = SL + ((u & 1) ^ 1) * (32 * LDT);
                const bf16x8 sx0 = *(const LAS bf16x8*)(S0 + (vt * 16 + fr) * LDT + fq * 8), sy0 = *(const LAS bf16x8*)(S0 + (vt2 * 16 + fr) * LDT + fq * 8);
                const bf16x8 sx1 = *(const LAS bf16x8*)(S0 + (vt * 16 + fr) * LDT + 32 + fq * 8), sy1 = *(const LAS bf16x8*)(S0 + (vt2 * 16 + fr) * LDT + 32 + fq * 8);
                sacc = __builtin_amdgcn_mfma_f32_16x16x32_bf16(p0, sx0, sacc, 0, 0, 0);
                yacc = __builtin_amdgcn_mfma_f32_16x16x32_bf16(sy0, q0, yacc, 0, 0, 0);
                sacc = __builtin_amdgcn_mfma_f32_16x16x32_bf16(p1, sx1, sacc, 0, 0, 0);
                yacc = __builtin_amdgcn_mfma_f32_16x16x32_bf16(sy1, q1, yacc, 0, 0, 0);
                { u32x2 w; w.x = pk2(yacc[0], yacc[1]); w.y = pk2(yacc[2], yacc[3]); *(u32x2*)(ybase + (size_t)ck * 4096) = w; }
                { u32x2 w; w.x = pk2(sacc[0], sacc[1]); w.y = pk2(sacc[2], sacc[3]); *(LAS u32x2*)(S1 + (vt * 16 + fr) * LDT + ct * 16 + 4 * fq) = w; }
                if (u == 0) { if (ck0 == 0) WKV_VMW(7); else WKV_VMW(9); }
                else if (u == 1) { if (ck0 == 0) WKV_VMW(8); else if (ck0 == 60) WKV_VMW(0); else WKV_VMW(9); }
                else { if (ck0 == 60) WKV_VMW(0); else WKV_VMW(9); }
                LDS_BARRIER();
            }
        }
#undef WKV_STAGE
#undef WKV_VMW
    }
}

__device__ __forceinline__ void phase_gn(const Frame& F, const bf16_t* Y, const float* BONUS, const bf16_t* V, const bf16_t* GATE, const float* lnw, const float* lnb, bf16_t* Z) {
    const int lane = F.lane, h = lane >> 2;
    for (int m = F.gw; m < T; m += F.NGW) {
        const size_t off = (size_t)m * D + 16 * lane;
        float y[16]; float s = 0.f;
        const int bb_ = m / SEQ, t_ = m - bb_ * SEQ, pr_ = SEQ - 1 - t_;
        const bf16_t* yf = Y + ((((size_t)(bb_ * 16 + h)) * 64 + (t_ >> 6)) * 64 + (t_ & 63)) * 64 + 16 * (lane & 3);
        const bf16_t* yb = Y + ((((size_t)(64 + bb_ * 16 + h)) * 64 + (pr_ >> 6)) * 64 + (pr_ & 63)) * 64 + 16 * (lane & 3);
#pragma unroll
        for (int q = 0; q < 2; ++q) { const u32x4 a = *(const u32x4*)(yf + 8 * q), b = *(const u32x4*)(yb + 8 * q);
#pragma unroll
            for (int j = 0; j < 4; ++j) { y[8 * q + 2 * j] = bf_lo(a[j]) + bf_lo(b[j]); y[8 * q + 2 * j + 1] = bf_hi(a[j]) + bf_hi(b[j]); s += y[8 * q + 2 * j] + y[8 * q + 2 * j + 1]; } }
        s += __shfl_xor(s, 1); s += __shfl_xor(s, 2);
        const float mean = s * (1.f / 64.f); float qq = 0.f;
#pragma unroll
        for (int j = 0; j < 16; ++j) { y[j] -= mean; qq += y[j] * y[j]; }
        qq += __shfl_xor(qq, 1); qq += __shfl_xor(qq, 2);
        const float rs = __builtin_amdgcn_rsqf(qq * (1.f / 64.f) + GN_EPS);
        const float bon = BONUS[(size_t)m * RH + h] + BONUS[(size_t)T * RH + (size_t)m * RH + h];
        const u32x4 g0 = *(const u32x4*)(GATE + off), g1 = *(const u32x4*)(GATE + off + 8);
        float o[16];
#pragma unroll
        for (int q = 0; q < 4; ++q) { const f32x4 w = *(const f32x4*)(lnw + 16 * lane + 4 * q), bb = *(const f32x4*)(lnb + 16 * lane + 4 * q); const u32x2 vb = *(const u32x2*)(V + off + 4 * q);
            const f32x4 vv = (f32x4){bf_lo(vb.x), bf_hi(vb.x), bf_lo(vb.y), bf_hi(vb.y)};
#pragma unroll
            for (int j = 0; j < 4; ++j) o[4 * q + j] = y[4 * q + j] * rs * w[j] + bb[j] + bon * vv[j]; }
#pragma unroll
        for (int q = 0; q < 4; ++q) { o[2 * q] *= bf_lo(g0[q]); o[2 * q + 1] *= bf_hi(g0[q]); o[8 + 2 * q] *= bf_lo(g1[q]); o[8 + 2 * q + 1] *= bf_hi(g1[q]); }
        u32x4 w0, w1; w0.x = pk2(o[0], o[1]); w0.y = pk2(o[2], o[3]); w0.z = pk2(o[4], o[5]); w0.w = pk2(o[6], o[7]); w1.x = pk2(o[8], o[9]); w1.y = pk2(o[10], o[11]); w1.z = pk2(o[12], o[13]); w1.w = pk2(o[14], o[15]);
        __builtin_nontemporal_store(w0, (u32x4*)(Z + off)); __builtin_nontemporal_store(w1, (u32x4*)(Z + off + 8));
    }
}

constexpr int PH_PER_LAYER = 16, PH_FINAL = 1 + NL * PH_PER_LAYER, PH_COUNT = PH_FINAL + 1;
constexpr size_t TILE1024 = (size_t)256 * 1024 * 2;
typedef pg8::GroupSched<64, 4, 1, 0, 0, 0, 0, 0, TILE1024, TILE1024> SchedN4;
typedef pg8::GroupSched<64, 12, 1, 0, 0, 0, 0, 0, TILE1024, TILE1024> SchedN12;
typedef pg8::GroupSched<64, 4, 3, 0, 0, (size_t)T * D * 2, SZ_SQ, 0, TILE1024, TILE1024> SchedRKV;
typedef pg8::GroupSched<64, 1, 3, 0, 0, (size_t)T * D * 2, TILE1024, 0, TILE1024, TILE1024> SchedL1;
typedef pg8::GroupSched<64, 4, 5, 0, 3, (size_t)T * 128 * 2, (size_t)1024 * 128 * 2, 0, (size_t)256 * 128 * 2, (size_t)256 * 128 * 2> SchedL2;
typedef pg8::GroupSched<4, 4, 4, 0, 0, SZ_SQ, 2 * SZ_SQ, 0, TILE1024, TILE1024> SchedKM;
typedef pg8::GroupSched<4, 4, 4, 0, 0, 2 * SZ_SQ, SZ_SQ, 0, TILE1024, TILE1024> SchedVT;
typedef pg8::GroupSched<128, 8, 1, 8, 0, 0, 0, (size_t)2048 * 1024, 0, TILE1024 / 2> SchedUp;
typedef pg8::GroupSched<128, 4, 1, 8, 0, 0, 0, SZ_SQ / 2, TILE1024 / 2, TILE1024 / 2> SchedDown;
typedef pg8::OneUnitSched<TILE1024, TILE1024> SchedOne;
template <bool VO>
struct FoldSched {
    const char* A0; const char* B0; int G, c;
    __device__ __forceinline__ bool next(int i, pg8::Unit& u) const {
        const int L = i * G + c; if (L >= 256) return false;
        const int l = L >> 6, b = (L >> 4) & 3, h = (L >> 2) & 3, t = L & 3;
        if (VO) { u.a = A0 + (size_t)l * SZ_SQ + (size_t)t * TILE1024 + h * 512; u.b = B0 + (size_t)l * SZ_SQ + (size_t)b * TILE1024 + h * 512; u.pm = t; u.pn = h; u.sub = l * 4 + b; }
        else { u.a = A0 + (size_t)l * SZ_SQ + (size_t)b * TILE1024 + h * 512; u.b = B0 + (size_t)l * SZ_SQ + (size_t)t * TILE1024 + h * 512; u.pm = 0; u.pn = t; u.sub = (l * 4 + b) * 4 + h; }
        return true;
    }
};
typedef pg8::GroupSched<64, 4, 1, 16, 0, 0, 0, SZ_SQ, TILE1024, TILE1024> SchedPVO;
typedef pg8::AttnSched<TILE1024, 512> SchedQK;
typedef pg8::AttnSched<512, TILE1024> SchedPV;

#ifndef PHMASK
#define PHMASK 0xFFFFFFFFu
#endif
#define PH_EN(k) (((PHMASK) >> (k)) & 1u)
#define PH_IN(id) (PH_EN(PHG) && lo <= (id) && (id) < hi)
#ifndef REPMASK
#define REPMASK 0u
#endif
#ifndef REPN
#define REPN 1
#endif
#define PH_IF(cond) if (cond) for (int rep_ = 0; rep_ < ((((REPMASK) >> PHG) & 1u) ? (REPN) : 1); ++rep_)
#define PH_SYNC(id) do { if ((id) + 1 < hi) xcd_barrier(bar); } while (0)
#define WSL unsigned char* const wsl = (unsigned char*)inp(args, I_WS)
#define WSP(T_, off) ((T_*)(wsl + (off)))
#define POOLP(T_, off) ((T_*)(wsl + WS_POOL + (off)))
#define HCUR WSP(bf16_t, (i & 1) ? WS_HB : WS_HA)
#define HPREV WSP(const bf16_t, (i & 1) ? WS_HA : WS_HB)
#define BX ((int)blockIdx.x)
template <int i>
__device__ __forceinline__ void run_layer(const Frame& F, const Args& args, const XcdBarrier& bar, const int lo, const int hi) {
    using namespace pg8;
    constexpr int base = 1 + i * PH_PER_LAYER, j = i >> 1;
    if constexpr ((i & 1) != 0) {
#define PHG 1
        PH_IF(PH_IN(base + 0)) { WSL;
            phase_entry_plain<0>(F, HPREV, HCUR, POOLP(const bf16_t, PO_YE), WSP(const int, WS_SLOT), inp(args, I_NMIX) + i * D, WSP(bf16_t, WS_XN), nullptr);
            PH_SYNC(base + 0); }
#undef PHG
#define PHG 22
        PH_IF(PH_IN(base + 1)) { WSL; phase_mix(F, WSP(const bf16_t, WS_XN), inp(args, I_MU) + (size_t)j * 6 * D, POOLP(bf16_t, PO_X6)); PH_SYNC(base + 1); }
#undef PHG
#define PHG 2
        PH_IF(PH_IN(base + 2)) { WSL;
            { SchedRKV S{(const char*)POOLP(bf16_t, PO_X6), (const char*)(wsl + WS_RKV + (size_t)j * 3 * SZ_SQ), F.G, BX};
              EpiBf16 E{POOLP(bf16_t, PO_RKV), 1024, (size_t)T * D, 1.f}; gemm_phase<1024, 1024, 1024, EpiBf16, SchedRKV, true>(F.lds, S, E); }
            { SchedL1 S{(const char*)(POOLP(bf16_t, PO_X6) + (size_t)3 * T * D), (const char*)(wsl + WS_L1 + (size_t)j * SZ_L1), F.G, BX};
              EpiLora1 E{POOLP(bf16_t, PO_LORA)}; gemm_phase<1024, 1024, 1024, EpiLora1, SchedL1, true>(F.lds, S, E); }
            PH_SYNC(base + 2); }
#undef PHG
#define PHG 3
        PH_IF(PH_IN(base + 3)) { WSL;
            SchedL2 S{(const char*)POOLP(bf16_t, PO_LORA), (const char*)(wsl + WS_L2 + (size_t)j * SZ_L2), F.G, BX};
            EpiLora2 E{POOLP(bf16_t, PO_LOGW), POOLP(bf16_t, PO_ICLR), POOLP(bf16_t, PO_GATE), inp(args, I_W0) + (size_t)j * 2 * D, inp(args, I_A0) + (size_t)j * 2 * D};
            gemm_phase<128, 128, 128, EpiLora2, SchedL2, true>(F.lds, S, E);
            PH_SYNC(base + 3); }
#undef PHG
#define PHG 4
        PH_IF(PH_IN(base + 4)) { WSL;
            const bf16_t* RKV = POOLP(const bf16_t, PO_RKV);
            phase_wkv_prep2(F, RKV, RKV + (size_t)T * D, RKV + (size_t)2 * T * D, POOLP(const bf16_t, PO_LOGW), POOLP(const bf16_t, PO_ICLR), inp(args, I_KK) + j * D, inp(args, I_KA) + j * D, inp(args, I_RK) + j * D,
                            POOLP(bf16_t, PO_CP), POOLP(bf16_t, PO_CQ), POOLP(bf16_t, PO_CG), POOLP(bf16_t, PO_Y), POOLP(float, PO_BONUS));
            PH_SYNC(base + 4); }
#undef PHG
#define PHG 21
        PH_IF(PH_IN(base + 5)) { WSL;
            phase_wkv_scan(F, POOLP(const bf16_t, PO_CP), POOLP(const bf16_t, PO_CQ), POOLP(const bf16_t, PO_CG), POOLP(bf16_t, PO_Y));
#ifdef DBG_WKV
            { const bf16_t* RKV = POOLP(const bf16_t, PO_RKV);
              phase_scan_seq(F, RKV, RKV + (size_t)T * D, RKV + (size_t)2 * T * D, POOLP(const float, PO_LOGW), POOLP(const bf16_t, PO_ICLR), inp(args, I_KK) + j * D, inp(args, I_KA) + j * D, inp(args, I_RK) + j * D, WSP(float, WS_WGU)); }
#endif
            PH_SYNC(base + 5); }
#undef PHG
#define PHG 5
        PH_IF(PH_IN(base + 6)) { WSL;
            phase_gn(F, POOLP(const bf16_t, PO_Y), POOLP(const float, PO_BONUS), POOLP(const bf16_t, PO_RKV) + (size_t)2 * T * D, POOLP(const bf16_t, PO_GATE), inp(args, I_LNW) + j * D, inp(args, I_LNB) + j * D, POOLP(bf16_t, PO_Z));
            PH_SYNC(base + 6); }
#undef PHG
#define PHG 6
        PH_IF(PH_IN(base + 7)) { WSL;
            SchedN4 S{(const char*)POOLP(bf16_t, PO_Z), (const char*)(wsl + WS_ROUT + (size_t)j * SZ_SQ), F.G, BX};
            EpiResidualT<false, true> E{HCUR, HCUR, WSP(float, WS_XN)}; gemm_phase<1024, 1024, 1024, EpiResidualT<false, true>, SchedN4, true>(F.lds, S, E);
            PH_SYNC(base + 7); }
#undef PHG
    } else {
#define PHG 7
        PH_IF(i > 0 && PH_IN(base + 0)) { WSL;
            phase_entry_plain<0>(F, HPREV, HCUR, POOLP(const bf16_t, PO_YE), WSP(const int, WS_SLOT), inp(args, I_NMIX) + i * D, WSP(bf16_t, WS_XN), nullptr);
            PH_SYNC(base + 0); }
#undef PHG
#define PHG 8
        PH_IF(PH_IN(base + 1)) { WSL;
            { SchedN12 S{(const char*)WSP(bf16_t, WS_XN), (const char*)(wsl + WS_CONVIN + (size_t)j * SZ_CONVIN), F.G, BX};
              EpiConvIn E{POOLP(bf16_t, PO_U), POOLP(bf16_t, PO_BG)}; gemm_phase<1024, 1024, 1024, EpiConvIn, SchedN12, true>(F.lds, S, E); }
            if (i == 0) {
                { SchedKM S{(const char*)(wsl + WS_MEMN), (const char*)(wsl + WS_WKV), F.G, BX};
                  EpiBf16 E{WSP(bf16_t, WS_KM), 1024, (size_t)1024 * 1024, 1.f}; gemm_phase<1024, 1024, 1024, EpiBf16, SchedKM, true>(F.lds, S, E); }
                { SchedKM S{(const char*)(wsl + WS_MEMN), (const char*)(wsl + WS_WKV + SZ_SQ), F.G, BX};
                  EpiBf16 E{WSP(bf16_t, WS_VT), 1024, (size_t)1024 * 1024, 1.f}; gemm_phase<1024, 1024, 1024, EpiBf16, SchedKM, true>(F.lds, S, E); }
            }
            PH_SYNC(base + 1); }
#undef PHG
#define PHG 9
        PH_IF(PH_IN(base + 2)) { WSL; phase_conv_ew(F, POOLP(const bf16_t, PO_U), POOLP(const bf16_t, PO_BG), inp(args, I_CONV_W) + (size_t)j * 3 * D, POOLP(bf16_t, PO_G));
            if (i == 0) {
                __syncthreads();
                { FoldSched<false> S{(const char*)(wsl + WS_KM), (const char*)(wsl + WS_WQ), F.G, BX};
                  EpiBf16 E{POOLP(bf16_t, PO_WQK), 1024, (size_t)256 * 1024, 1.f}; gemm_phase<1024, 1024, 256, EpiBf16, FoldSched<false>, true>(F.lds, S, E); }
                { FoldSched<true> S{(const char*)(wsl + WS_WO), (const char*)(wsl + WS_VT), F.G, BX};
                  EpiBf16 E{POOLP(bf16_t, PO_VOT), 1024, (size_t)1024 * 1024, 1.f}; gemm_phase<1024, 1024, 256, EpiBf16, FoldSched<true>, true>(F.lds, S, E); }
            }
            PH_SYNC(base + 2); }
#undef PHG
#define PHG 10
        PH_IF(PH_IN(base + 3)) { WSL;
            SchedN4 S{(const char*)POOLP(bf16_t, PO_G), (const char*)(wsl + WS_CONVOUT + (size_t)j * SZ_SQ), F.G, BX};
            if (i == 0) { EpiResidualT<true, true> E{inp(args, I_X), HCUR, WSP(float, WS_XN)}; gemm_phase<1024, 1024, 1024, EpiResidualT<true, true>, SchedN4, true>(F.lds, S, E); }
            else { EpiResidualT<false, true> E{HCUR, HCUR, WSP(float, WS_XN)}; gemm_phase<1024, 1024, 1024, EpiResidualT<false, true>, SchedN4, true>(F.lds, S, E); }
            PH_SYNC(base + 3); }
#undef PHG
    }
#define PHG 11
#undef PHG
#define PHG 12
    PH_IF(PH_IN(base + 9)) { WSL;
        const SchedN4 SM{nullptr, nullptr, F.G, BX};
        for (int it = 0; ; ++it) { Unit um; if (!SM.next(it, um)) break; const int pm = um.pm, h = um.pn, b = pm >> 4;
            LAS float* RS = (LAS float*)(F.lds + RING_BYTES);
            if (F.tid < 256) { const f32x4* pp = (const f32x4*)(WSP(const float, WS_XN) + (size_t)(pm * 256 + F.tid) * 16); const f32x4 a = pp[0], b = pp[1], c = pp[2], d = pp[3];
                const f32x4 t4 = (a + b) + (c + d); RS[F.tid] = __builtin_amdgcn_rsqf(((t4[0] + t4[1]) + (t4[2] + t4[3])) * (1.f / D) + RMS_EPS); }
            __syncthreads();
            { SchedOne S{(const char*)HCUR, (const char*)POOLP(bf16_t, PO_WQK) + (size_t)((i * 4 + b) * 4) * TILE1024, pm, h};
              EpiSoftmax E{POOLP(bf16_t, PO_P), RS, 1.4426950408889634f / 16.f}; gemm_phase<1024, 1024, 1024, EpiSoftmax, SchedOne, false>(F.lds, S, E); }
            VM_WAIT(); __syncthreads();
        }
        PH_SYNC(base + 9); }
#undef PHG
#define PHG 15
    PH_IF(PH_IN(base + 10)) { WSL;
        SchedPVO S{(const char*)POOLP(bf16_t, PO_P), (const char*)POOLP(bf16_t, PO_VOT) + (size_t)i * 4 * SZ_SQ, F.G, BX};
        EpiResidual E{HCUR, HCUR}; gemm_phase<1024, 1024, 1024, EpiResidual, SchedPVO, true>(F.lds, S, E);
        PH_SYNC(base + 10); }
#undef PHG
#define PHG 16
    int rtb = F.gw, rte = T, rts = F.NGW;
    if (F.G == 256) { const SchedN4 SR{nullptr, nullptr, F.G, BX}; Unit ur; if (SR.next(0, ur)) { rtb = ur.pm * 256 + ur.pn * 64 + F.wave; rte = ur.pm * 256 + ur.pn * 64 + 64; rts = NWAVES; } }
    PH_IF(PH_IN(base + 11)) { WSL; phase_router(F, HCUR, inp(args, I_NFFN) + i * D, inp(args, I_ROUTER) + (size_t)i * D * NE, POOLP(unsigned char, PO_XE), WSP(float, WS_PROBS), rtb, rte, rts); PH_SYNC(base + 11); }
#undef PHG
#define PHG 17
    PH_IF(PH_IN(base + 12)) { WSL;
        if (F.G > 64) {
            if (BX < 64) { if (!(args.dbg & 64)) select_pair(F, BX, WSP(const float, WS_PROBS), WSP(int, WS_SLOT), WSP(float, WS_AFF), WSP(int, WS_GIDX)); }
            else if (!(args.dbg & 32)) moe_convert(F, args, i, (BX - 64) * NWAVES + F.wave, (F.G - 64) * NWAVES);
        } else {
            for (int pr = BX; pr < 64; pr += F.G) select_pair(F, pr, WSP(const float, WS_PROBS), WSP(int, WS_SLOT), WSP(float, WS_AFF), WSP(int, WS_GIDX));
            moe_convert(F, args, i, BX * NWAVES + F.wave, F.G * NWAVES);
        }
        PH_SYNC(base + 12); }
#undef PHG
#define PHG 18
    PH_IF(PH_IN(base + 13)) { WSL;
        SchedUp S{(const char*)POOLP(unsigned char, PO_XE), (const char*)(wsl + WS_WGU), F.G, BX};
        EpiSwiGLU8 E{POOLP(unsigned char, PO_HID)}; gemm_phase<512, 512, 512, EpiSwiGLU8, SchedUp, true, true, true, true>(F.lds, S, E, WSP(const int, WS_GIDX));
        PH_SYNC(base + 13); }
#undef PHG
#define PHG 19
    PH_IF(PH_IN(base + 14)) { WSL;
        SchedDown S{(const char*)POOLP(bf16_t, PO_HID), (const char*)(wsl + WS_WD), F.G, BX};
        EpiDown E{POOLP(bf16_t, PO_YE), WSP(const float, WS_AFF), 1.f / (FP8_SH * FP8_SW)}; gemm_phase<512, 512, 512, EpiDown, SchedDown, true, true, false, true>(F.lds, S, E);
        PH_SYNC(base + 14); }
#undef PHG
}

__global__ void __launch_bounds__(NTHREADS, 2) fwd_kernel(Args args) {
    extern __shared__ __attribute__((aligned(16))) unsigned char lds_raw[];
    Frame F;
    F.lds = (LAS unsigned char*)lds_raw;
    F.tid = threadIdx.x; F.lane = F.tid & 63; F.wave = __builtin_amdgcn_readfirstlane(F.tid >> 6);
    F.G = gridDim.x; { const int bx = blockIdx.x; const int vcu = (F.G % 8 == 0) ? (bx % 8) * (F.G / 8) + bx / 8 : bx; F.gw = vcu * NWAVES + F.wave; F.NGW = F.G * NWAVES; }
    F.ws = args.ws;
    for (int u = F.tid; u < (LDS_BYTES - LDSCTL_OFF) / 4; u += NTHREADS) ((LAS unsigned*)(F.lds + LDSCTL_OFF))[u] = 0u;
    __syncthreads();
    const XcdBarrier bar = xcd_barrier_post((unsigned*)(args.ws + WS_CTL) + CW_BAR, (volatile LAS unsigned*)(F.lds + MISC_OFF) + 8);
    const int lo = args.ph_lo, hi = args.ph_hi;
#define PHG 0
    PH_IF(PH_IN(0)) { phase_prologue(F, args); PH_SYNC(0); }
#undef PHG
    run_layer<0>(F, args, bar, lo, hi);
    run_layer<1>(F, args, bar, lo, hi);
    run_layer<2>(F, args, bar, lo, hi);
    run_layer<3>(F, args, bar, lo, hi);
#define PHG 20
    PH_IF(PH_IN(PH_FINAL)) { WSL;
        phase_entry_plain<1>(F, WSP(const bf16_t, WS_HB), nullptr, POOLP(const bf16_t, PO_YE), WSP(const int, WS_SLOT), inp(args, I_NFINAL), nullptr, args.out); }
#undef PHG
}

extern "C" void kernel_launch(void* const* d_in, const int* in_sizes, int n_in, void* d_out, int out_size, void* d_ws, size_t ws_size, hipStream_t stream) {
    static int grid = 0;
    if (grid == 0) {
        if (n_in != 33 || in_sizes[0] != T * D || out_size != T * D || ws_size < WS_END) { fprintf(stderr, "kernel_launch: unexpected problem (n_in %d, in0 %d, out %d, ws %zu < %zu)\n", n_in, n_in > 0 ? in_sizes[0] : -1, out_size, ws_size, (size_t)WS_END); grid = -1; return; }
        int dev = 0, cus = 0, per_cu = 0;
        if (hipGetDevice(&dev) != hipSuccess || hipDeviceGetAttribute(&cus, hipDeviceAttributeMultiprocessorCount, dev) != hipSuccess) { grid = -1; return; }
        if (hipFuncSetAttribute((const void*)fwd_kernel, hipFuncAttributeMaxDynamicSharedMemorySize, LDS_BYTES) != hipSuccess) { fprintf(stderr, "kernel_launch: hipFuncSetAttribute failed\n"); grid = -1; return; }
        if (hipOccupancyMaxActiveBlocksPerMultiprocessor(&per_cu, (const void*)fwd_kernel, NTHREADS, LDS_BYTES) != hipSuccess || per_cu < 1) { fprintf(stderr, "kernel_launch: occupancy query says %d\n", per_cu); }
        (void)hipGetLastError();
        grid = cus;
    }
    if (grid < 0) return;
    (void)hipMemsetAsync((char*)d_ws + WS_CTL, 0, CTL_ZERO_BYTES, stream);
    Args a{};
    for (int i = 0; i < 33; ++i) a.in[i] = (const float*)d_in[i];
    a.in[33] = (const float*)d_ws; a.out = (float*)d_out; a.ws = (unsigned char*)d_ws; a.ph_lo = 0; a.ph_hi = PH_COUNT;
    hipLaunchKernelGGL(fwd_kernel, dim3(grid), dim3(NTHREADS), LDS_BYTES, stream, a);
#ifdef TIME_PHASES
#ifndef TIME_DBG
#define TIME_DBG 0
#endif
    { const int ids[] = {TIME_PHASES};
      for (int k = 0; k < (int)(sizeof(ids) / sizeof(ids[0])); ++k) { (void)hipMemsetAsync((char*)d_ws + WS_CTL, 0, 64 * 1024, stream); a.ph_lo = ids[k]; a.ph_hi = ids[k] + 1; a.dbg = TIME_DBG;
        hipLaunchKernelGGL(fwd_kernel, dim3(grid), dim3(NTHREADS), LDS_BYTES, stream, a); } }
#endif
}
```

```cpp
#include <hip/hip_runtime.h>
#include <cstdio>
#include <cstdint>

#define LAS __attribute__((address_space(3)))
#define GAS __attribute__((address_space(1)))
typedef unsigned short bf16_t;
typedef short bf16x8 __attribute__((ext_vector_type(8)));
typedef float f32x4 __attribute__((ext_vector_type(4)));
typedef float f32x2 __attribute__((ext_vector_type(2)));
typedef unsigned u32x4 __attribute__((ext_vector_type(4)));
typedef unsigned u32x2 __attribute__((ext_vector_type(2)));

constexpr int NB = 4, SEQ = 4096, D = 1024, T = NB * SEQ, NL = 4;
constexpr int MEML = 256, XH = 4, XHD = 256;
constexpr int NE = 16, CAP = 512, NSLOT = NB * NE * CAP;
constexpr int RH = 16, RN = 64;
constexpr float RMS_EPS = 1e-6f, GN_EPS = 64e-5f;

constexpr size_t MiB = 1u << 20;
constexpr size_t WS_CTL = 0, CTL_ZERO_BYTES = 64 * 1024;
constexpr size_t WS_W = 1 * MiB;
constexpr size_t SZ_CONVIN = (size_t)3072 * 1024 * 2, SZ_SQ = (size_t)1024 * 1024 * 2, SZ_L1 = (size_t)768 * 1024 * 2, SZ_L2 = (size_t)5 * 1024 * 128 * 2;
constexpr size_t WS_CONVIN = WS_W;
constexpr size_t WS_CONVOUT = WS_CONVIN + 2 * SZ_CONVIN;
constexpr size_t WS_RKV = WS_CONVOUT + 2 * SZ_SQ;
constexpr size_t WS_L1 = WS_RKV + 6 * SZ_SQ;
constexpr size_t WS_L2 = WS_L1 + 2 * SZ_L1;
constexpr size_t WS_ROUT = WS_L2 + 2 * SZ_L2;
constexpr size_t WS_WQ = WS_ROUT + 2 * SZ_SQ;
constexpr size_t WS_WKV = WS_WQ + 4 * SZ_SQ;
constexpr size_t WS_WO = WS_WKV + 8 * SZ_SQ;
constexpr size_t WS_WGU = WS_WO + 4 * SZ_SQ;
constexpr size_t WS_WD = WS_WGU + 64 * MiB;
constexpr size_t WS_HA = WS_WD + 32 * MiB;
constexpr size_t WS_HB = WS_HA + 64 * MiB;
constexpr size_t WS_XN = WS_HB + 64 * MiB;
constexpr size_t WS_MEMN = WS_XN + 32 * MiB;
constexpr size_t WS_KM = WS_MEMN + 8 * MiB;
constexpr size_t WS_VT = WS_KM + 8 * MiB;
constexpr size_t WS_PROBS = WS_VT + 8 * MiB;
constexpr size_t WS_SLOT = WS_PROBS + 1 * MiB;
constexpr size_t WS_AFF = WS_SLOT + 1 * MiB;
constexpr size_t WS_GIDX = WS_AFF + 512 * 1024;
constexpr size_t WS_POOL = WS_AFF + 1 * MiB;
constexpr size_t PO_U = 0, PO_BG = 32 * MiB, PO_G = 64 * MiB;
constexpr size_t PO_Q = 0, PO_P = 32 * MiB, PO_O = 64 * MiB;
constexpr size_t PO_XE = 0, PO_HID = 64 * MiB, PO_YE = 192 * MiB;
constexpr size_t PO_X6 = 0;
constexpr size_t PO_CP = 0, PO_CQ = 64 * MiB, PO_CG = 128 * MiB;
constexpr size_t PO_Z = 0;
constexpr size_t PO_RKV = 192 * MiB;
constexpr size_t PO_LORA = 288 * MiB;
constexpr size_t PO_LOGW = 300 * MiB;
constexpr size_t PO_ICLR = 428 * MiB;
constexpr size_t PO_GATE = 492 * MiB;
constexpr size_t PO_Y = 524 * MiB;
constexpr size_t PO_WQK = 588 * MiB;
constexpr size_t PO_VOT = 620 * MiB;
constexpr size_t PO_BONUS = 652 * MiB;
constexpr size_t WS_END = WS_POOL + 654 * MiB;
static_assert(WS_END <= 1024 * MiB, "workspace map exceeds 1 GiB");

constexpr int CW_TMO = 0, CW_BAR = 4096;

constexpr int NWAVES = 8, NTHREADS = 512;
constexpr int RING_BYTES = 131072, LDS_BYTES = 163840, LDSCTL_OFF = LDS_BYTES - 1024, MISC_OFF = LDSCTL_OFF + 320;

typedef __bf16 hwbf16x2 __attribute__((ext_vector_type(2)));
__device__ __forceinline__ unsigned pk2(float lo, float hi) { const f32x2 v = {lo, hi}; const hwbf16x2 b = __builtin_convertvector(v, hwbf16x2); return __builtin_bit_cast(unsigned, b); }
__device__ __forceinline__ unsigned f2bf(float f) { return pk2(f, 0.f) & 0xffffu; }
typedef int i32x8 __attribute__((ext_vector_type(8)));
typedef int i32x4 __attribute__((ext_vector_type(4)));
__device__ __forceinline__ unsigned pk_fp8x4(float a, float b, float c, float d) {
    a = __builtin_amdgcn_fmed3f(a, -448.f, 448.f); b = __builtin_amdgcn_fmed3f(b, -448.f, 448.f); c = __builtin_amdgcn_fmed3f(c, -448.f, 448.f); d = __builtin_amdgcn_fmed3f(d, -448.f, 448.f);
    unsigned p = (unsigned)__builtin_amdgcn_cvt_pk_fp8_f32(a, b, 0, false); return (unsigned)__builtin_amdgcn_cvt_pk_fp8_f32(c, d, (int)p, true); }
constexpr float FP8_SX = 32.f, FP8_SW = 512.f, FP8_SH = 16.f;
__device__ __forceinline__ float bf_lo(unsigned w) { return __builtin_bit_cast(float, w << 16); }
__device__ __forceinline__ float bf_hi(unsigned w) { return __builtin_bit_cast(float, w & 0xffff0000u); }
__device__ __forceinline__ float wave_sum(float v) {
#pragma unroll
    for (int o = 1; o < 64; o <<= 1) v += __shfl_xor(v, o);
    return v;
}
__device__ __forceinline__ float sigmoidf_(float x) { return __builtin_amdgcn_rcpf(1.f + __expf(-x)); }

__device__ __forceinline__ int rs16_index(int lane) { return ((lane >> 5) & 1) * 8 + ((lane >> 4) & 1) * 4 + ((lane >> 3) & 1) * 2 + ((lane >> 2) & 1); }
__device__ __forceinline__ float reduce_scatter16(const float (&v)[16], int lane) {
    float a[8], b[4], c[2], d;
    { const bool hi = (lane & 32) != 0;
#pragma unroll
      for (int i = 0; i < 8; ++i) { const float keep = hi ? v[8 + i] : v[i], send = hi ? v[i] : v[8 + i]; a[i] = keep + __shfl_xor(send, 32); } }
    { const bool hi = (lane & 16) != 0;
#pragma unroll
      for (int i = 0; i < 4; ++i) { const float keep = hi ? a[4 + i] : a[i], send = hi ? a[i] : a[4 + i]; b[i] = keep + __shfl_xor(send, 16); } }
    { const bool hi = (lane & 8) != 0;
#pragma unroll
      for (int i = 0; i < 2; ++i) { const float keep = hi ? b[2 + i] : b[i], send = hi ? b[i] : b[2 + i]; c[i] = keep + __shfl_xor(send, 8); } }
    { const bool hi = (lane & 4) != 0; const float keep = hi ? c[1] : c[0], send = hi ? c[0] : c[1]; d = keep + __shfl_xor(send, 4); }
    d += __shfl_xor(d, 2); d += __shfl_xor(d, 1);
    return d;
}
#define LDS_WAIT() asm volatile("s_waitcnt lgkmcnt(0)" ::: "memory")
#define LDS_BARRIER() do { asm volatile("s_waitcnt lgkmcnt(0)" ::: "memory"); __builtin_amdgcn_s_barrier(); asm volatile("" ::: "memory"); } while (0)
#define VM_WAIT() asm volatile("s_waitcnt vmcnt(0)" ::: "memory")

namespace pg8 {
constexpr int BM = 256, BK = 64, HALF = 128, HTB = HALF * BK * 2, STAGE_BYTES = 8 * HTB, NXCD = 8, WGM = 8;
__host__ __device__ __forceinline__ int lds_byte(int r, int c) { const int st = (r >> 4) * 2 + (c >> 5), rr = r & 15, cc = c & 31, ob = rr * 64 + cc * 2; return st * 1024 + (ob ^ (((ob >> 9) & 1) << 5)); }
__host__ __device__ __forceinline__ void stage_rc(int b, int& R, int& C) { const int st = b / 1024, sb = b % 1024, swz = sb ^ (((sb >> 9) & 1) << 5); R = (st >> 1) * 16 + swz / 64; C = (st & 1) * 32 + (swz % 64) / 2; }
__host__ __device__ __forceinline__ int perm32(int rho) { const int n = rho >> 4, i = rho & 15; return 8 * (i >> 2) + 4 * n + (i & 3); }

struct Unit { const char* a; const char* b; int pm, pn, sub; };

__device__ __forceinline__ unsigned cvt_pk_bf16(float lo, float hi) { return pk2(lo, hi); }

template <int LDA, int LDB, int KDIM, class Epi, class Sched, bool ALIGN_EPI = false, bool SP2 = true, bool GATHER = false, bool FP8 = false, bool HALFN = false>
__device__ __forceinline__ void gemm_phase(LAS unsigned char* lds, const Sched& S, const Epi& E, const int* gidx = nullptr) {
    const int tid = threadIdx.x, wid = __builtin_amdgcn_readfirstlane(tid >> 6), lane = tid & 63, wr = wid >> 2, wc = wid & 3, fr = lane & 15, fq = lane >> 4;
    constexpr int nt = KDIM / BK;
    unsigned voffA[2], voffB[2];
    unsigned gA0[2], gA1[2], nA0[2], nA1[2]; int stR[2], stC[2];
#pragma unroll
    for (int i = 0; i < 2; ++i) { int R, C; stage_rc(tid * 16 + i * 8192, R, C); const int Rb = Epi::PERM ? ((R & ~31) + perm32(R & 31)) : R;
        voffA[i] = (unsigned)(R * LDA + C) * 2u; voffB[i] = (unsigned)(Rb * LDB + C) * 2u; if constexpr (GATHER) { stR[i] = R; stC[i] = C; } }
#define PG8_GATHER_OFFS(o0, o1, pm_) do { _Pragma("unroll") for (int i_ = 0; i_ < 2; ++i_) { \
        o0[i_] = (unsigned)(gidx[(pm_) * BM + stR[i_]] * LDA + stC[i_]) * 2u; o1[i_] = (unsigned)(gidx[(pm_) * BM + HALF + stR[i_]] * LDA + stC[i_]) * 2u; } } while (0)
#define PG8_STAGE_A(bufoff, base, h, nextunit) do { if constexpr (GATHER) { if (nextunit) { if ((h) == 0) PG8_STAGE(bufoff, base, nA0); else PG8_STAGE(bufoff, base, nA1); } else { if ((h) == 0) PG8_STAGE(bufoff, base, gA0); else PG8_STAGE(bufoff, base, gA1); } } \
        else PG8_STAGE(bufoff, (base) + (h) * hstepA, voffA); } while (0)
    constexpr size_t kstep = (size_t)(BK * 2);
    constexpr size_t hstepA = (size_t)HALF * LDA * 2, hstepB = (size_t)HALF * LDB * 2;
    const unsigned ldsw = (unsigned)wid * 1024u;
    const int aoff = FP8 ? lds_byte(wr * 64 + fr, fq * 16) + (fq & 1) * 16 : lds_byte(wr * 64 + fr, fq * 8), boff = FP8 ? lds_byte(wc * 32 + fr, fq * 16) + (fq & 1) * 16 : lds_byte(wc * 32 + fr, fq * 8);
    const int kst = FP8 ? 16 - (fq & 1) * 32 : 1024;
    int sc1 = 0x7f7f7f7f; if constexpr (FP8) asm volatile("" : "+v"(sc1));
#define PG8_SA(b, h) (((b) * 2 + (h)) * HTB)
#define PG8_SB(b, h) ((4 + (b) * 2 + (h)) * HTB)
#define PG8_STAGE(bufoff, gbase, voff) do { _Pragma("unroll") for (int _i = 0; _i < 2; ++_i) \
        __builtin_amdgcn_global_load_lds((const unsigned*)((const char*)(gbase) + (voff)[_i]), (LAS unsigned*)(lds + (bufoff) + ldsw + _i * 8192), 16, 0, 0); } while (0)
#define PG8_LDA(dst, b, h) do { _Pragma("unroll") for (int m = 0; m < 4; ++m) _Pragma("unroll") for (int k = 0; k < 2; ++k) dst[m][k] = *(const LAS bf16x8*)(lds + PG8_SA(b, h) + aoff + m * 2048 + k * kst); } while (0)
#define PG8_LDB(dst, b, h) do { _Pragma("unroll") for (int n = 0; n < 2; ++n) _Pragma("unroll") for (int k = 0; k < 2; ++k) dst[n][k] = *(const LAS bf16x8*)(lds + PG8_SB(b, h) + boff + n * 2048 + k * kst); } while (0)
#define PG8_MMA(ai, bj, At, Bt) do { __builtin_amdgcn_s_setprio(1); _Pragma("unroll") for (int m = 0; m < 4; ++m) _Pragma("unroll") for (int n = 0; n < 2; ++n) { \
        if constexpr (FP8) { const i32x8 a8 = __builtin_shufflevector(__builtin_bit_cast(i32x4, At[m][0]), __builtin_bit_cast(i32x4, At[m][1]), 0, 1, 2, 3, 4, 5, 6, 7), b8 = __builtin_shufflevector(__builtin_bit_cast(i32x4, Bt[n][0]), __builtin_bit_cast(i32x4, Bt[n][1]), 0, 1, 2, 3, 4, 5, 6, 7); \
            asm volatile("v_mfma_scale_f32_16x16x128_f8f6f4 %0, %1, %2, %0, %3, %3 op_sel_hi:[0,0,0]" : "+v"(acc[ai][bj][m][n]) : "v"(b8), "v"(a8), "v"(sc1)); } \
        else { _Pragma("unroll") for (int k = 0; k < 2; ++k) acc[ai][bj][m][n] = __builtin_amdgcn_mfma_f32_16x16x32_bf16(Bt[n][k], At[m][k], acc[ai][bj][m][n], 0, 0, 0); } } __builtin_amdgcn_s_setprio(0); } while (0)
#define PG8_WAIT_V(n) asm volatile("s_waitcnt vmcnt(" #n ")" ::: "memory")
#define PG8_WAIT_L(n) asm volatile("s_waitcnt lgkmcnt(" #n ")" ::: "memory")
#define PG8_BAR __builtin_amdgcn_s_barrier()
#define PG8_SCHED __builtin_amdgcn_sched_barrier(0)
    Unit cur, nxt; int ui = 0;
    if (!S.next(0, cur)) return;
    f32x4 acc[2][2][4][2];
#pragma unroll
    for (int a = 0; a < 2; ++a)
#pragma unroll
        for (int b = 0; b < 2; ++b)
#pragma unroll
            for (int m = 0; m < 4; ++m)
#pragma unroll
                for (int n = 0; n < 2; ++n) acc[a][b][m][n] = (f32x4){0.f, 0.f, 0.f, 0.f};
    bf16x8 At[4][2], B0[2][2], B1[2][2];
    const char* cA = cur.a; const char* cB = cur.b;
    if constexpr (GATHER) PG8_GATHER_OFFS(gA0, gA1, cur.pm);
    static_assert(SP2, "only the SP2 K-loop is kept");
    PG8_STAGE(PG8_SB(0, 0), cB, voffB); if constexpr (!HALFN) PG8_STAGE(PG8_SB(0, 1), cB + hstepB, voffB); PG8_STAGE_A(PG8_SA(0, 0), cA, 0, false); PG8_STAGE_A(PG8_SA(0, 1), cA, 1, false);
    if (wr == 1) PG8_BAR;
    PG8_WAIT_V(2); PG8_BAR;
    PG8_STAGE(PG8_SB(1, 0), cB + kstep, voffB); PG8_STAGE_A(PG8_SA(1, 0), cA + kstep, 0, false); if constexpr (!HALFN) PG8_STAGE(PG8_SB(1, 1), cB + hstepB + kstep, voffB);
    if constexpr (HALFN) PG8_WAIT_V(4); else PG8_WAIT_V(6);
    PG8_BAR;
    for (;;) {
        const bool has_next = S.next(ui + 1, nxt);
        const char* nA = has_next ? nxt.a : cA; const char* nB = has_next ? nxt.b : cB;
        if constexpr (GATHER) { if (has_next) PG8_GATHER_OFFS(nA0, nA1, nxt.pm); else { nA0[0] = gA0[0]; nA0[1] = gA0[1]; nA1[0] = gA1[0]; nA1[1] = gA1[1]; } }
        int ntv = nt; if constexpr (FP8) asm volatile("" : "+s"(ntv));
#pragma unroll 1
        for (int t = 0; t < ntv; t += 2) {
            const bool last = (t == ntv - 2);
            const char* a1 = cA + (size_t)(t + 1) * kstep;
            const char* a2 = last ? nA : cA + (size_t)(t + 2) * kstep; const char* b2 = last ? nB : cB + (size_t)(t + 2) * kstep;
            const char* a3 = a2 + kstep; const char* b3 = b2 + kstep;
#define PG8_WAIT_VK do { if constexpr (HALFN) PG8_WAIT_V(6); else PG8_WAIT_V(8); } while (0)
            PG8_LDB(B0, 0, 0); if constexpr (!HALFN) PG8_LDB(B1, 0, 1); PG8_SCHED; PG8_LDA(At, 0, 0); PG8_STAGE_A(PG8_SA(1, 1), a1, 1, false);
            PG8_WAIT_VK; PG8_WAIT_L(0); PG8_BAR; PG8_MMA(0, 0, At, B0); if constexpr (!HALFN) PG8_MMA(0, 1, At, B1); PG8_BAR; PG8_SCHED;
            PG8_LDA(At, 0, 1); PG8_STAGE(PG8_SB(0, 0), b2, voffB); if constexpr (!HALFN) PG8_STAGE(PG8_SB(0, 1), b2 + hstepB, voffB); PG8_STAGE_A(PG8_SA(0, 0), a2, 0, last);
            PG8_WAIT_VK; PG8_WAIT_L(0); PG8_BAR; PG8_MMA(1, 0, At, B0); if constexpr (!HALFN) PG8_MMA(1, 1, At, B1); PG8_BAR; PG8_SCHED;
            PG8_LDB(B0, 1, 0); if constexpr (!HALFN) PG8_LDB(B1, 1, 1); PG8_SCHED; PG8_LDA(At, 1, 0); PG8_STAGE_A(PG8_SA(0, 1), a2, 1, last);
            PG8_WAIT_VK; PG8_WAIT_L(0); PG8_BAR; PG8_MMA(0, 0, At, B0); if constexpr (!HALFN) PG8_MMA(0, 1, At, B1); PG8_BAR; PG8_SCHED;
            PG8_LDA(At, 1, 1); PG8_STAGE(PG8_SB(1, 0), b3, voffB); if constexpr (!HALFN) PG8_STAGE(PG8_SB(1, 1), b3 + hstepB, voffB); PG8_STAGE_A(PG8_SA(1, 0), a3, 0, last);
            PG8_WAIT_VK; PG8_WAIT_L(0); PG8_BAR; PG8_MMA(1, 0, At, B0); if constexpr (!HALFN) PG8_MMA(1, 1, At, B1); PG8_BAR; PG8_SCHED;
#undef PG8_WAIT_VK
        }
        if constexpr (FP8) {
#pragma unroll
            for (int a_ = 0; a_ < 2; ++a_)
#pragma unroll
                for (int b_ = 0; b_ < 2; ++b_)
                    asm volatile("s_nop 15\n\ts_nop 3" : "+v"(acc[a_][b_][0][0]), "+v"(acc[a_][b_][0][1]), "+v"(acc[a_][b_][1][0]), "+v"(acc[a_][b_][1][1]), "+v"(acc[a_][b_][2][0]), "+v"(acc[a_][b_][2][1]), "+v"(acc[a_][b_][3][0]), "+v"(acc[a_][b_][3][1])); }
        if constexpr (ALIGN_EPI) { if (wr == 0) PG8_BAR; }
        if constexpr (!Epi::AFTER_DRAIN) { E(acc, cur, wr, wc, fr, fq); }
        if (!has_next) break;
#pragma unroll
        for (int a = 0; a < 2; ++a)
#pragma unroll
            for (int b = 0; b < 2; ++b)
#pragma unroll
                for (int m = 0; m < 4; ++m)
#pragma unroll
                    for (int n = 0; n < 2; ++n) acc[a][b][m][n] = (f32x4){0.f, 0.f, 0.f, 0.f};
        cur = nxt; cA = nA; cB = nB; ++ui;
        if constexpr (GATHER) { gA0[0] = nA0[0]; gA0[1] = nA0[1]; gA1[0] = nA1[0]; gA1[1] = nA1[1]; }
        if constexpr (ALIGN_EPI) { if (wr == 1) PG8_BAR; }
    }
    PG8_WAIT_V(0);
    if constexpr (!ALIGN_EPI) { if (wr == 0) PG8_BAR; }
    PG8_BAR;
    if constexpr (Epi::AFTER_DRAIN) { E.fused(acc, cur, wr, wc, fr, fq, lds, wid, lane); }
#undef PG8_GATHER_OFFS
#undef PG8_STAGE_A
#undef PG8_SA
#undef PG8_SB
#undef PG8_STAGE
#undef PG8_LDA
#undef PG8_LDB
#undef PG8_MMA
#undef PG8_WAIT_V
#undef PG8_WAIT_L
#undef PG8_BAR
#undef PG8_SCHED
}

template <int NM, int NN, int NSUB, int PMDIV, int AMOD, size_t SA, size_t SB, size_t SBE, size_t TA, size_t TB>
struct GroupSched {
    const char* A0; const char* B0; int G, c;
    __device__ __forceinline__ bool next(int i, Unit& u) const {
        constexpr int per = NM * NN, nwg = NSUB * per; const int L = i * G + c; if (L >= nwg) return false;
        int wgid = L; { constexpr int q = nwg / NXCD, r = nwg % NXCD; const int xcd = wgid % NXCD, off = wgid / NXCD; wgid = (xcd < r ? xcd * (q + 1) : r * (q + 1) + (xcd - r) * q) + off; }
        const int sub = wgid / per, w = wgid - sub * per;
        constexpr int nig = WGM * NN; const int gid = w / nig, fm = gid * WGM, gsz = (NM - fm) < WGM ? (NM - fm) : WGM;
        u.pm = fm + ((w % nig) % gsz); u.pn = (w % nig) / gsz; u.sub = sub;
        int asub = sub; if constexpr (AMOD != 0) asub = sub % AMOD;
        int pe = 0; if constexpr (PMDIV != 0) pe = u.pm / PMDIV;
        u.a = A0 + (size_t)asub * SA + (size_t)u.pm * TA; u.b = B0 + (size_t)sub * SB + (size_t)pe * SBE + (size_t)u.pn * TB; return true;
    }
};
template <size_t TA, size_t TB>
struct OneUnitSched {
    const char* A0; const char* B0; int pm, pn;
    __device__ __forceinline__ bool next(int i, Unit& u) const { if (i > 0) return false; u.pm = pm; u.pn = pn; u.sub = 0; u.a = A0 + (size_t)pm * TA; u.b = B0 + (size_t)pn * TB; return true; }
};
template <size_t SBB, size_t SBH>
struct AttnSched {
    const char* A0; const char* B0; int G, c, only;
    __device__ __forceinline__ bool next(int i, Unit& u) const {
        int L; if (only >= 0) { if (i > 0) return false; L = only; } else { L = i * G + c; if (L >= 256) return false; }
        const int pm = L >> 2, h = L & 3, b = pm >> 4;
        u.pm = pm; u.pn = h; u.sub = 0;
        u.a = A0 + (size_t)pm * (256 * 1024 * 2) + (size_t)h * 512; u.b = B0 + (size_t)b * SBB + (size_t)h * SBH; return true;
    }
};

#define EPI_ROWLOOP for (int ai = 0; ai < 2; ++ai) _Pragma("unroll") for (int m = 0; m < 4; ++m)
typedef const f32x4 (&AccT)[2][2][4][2];

struct EpiBf16 {
    static constexpr bool PERM = true, AFTER_DRAIN = false;
    bf16_t* O; int ldc; size_t sub_stride; float scale;
    __device__ __forceinline__ void operator()(AccT acc, const Unit& u, int wr, int wc, int fr, int fq) const {
        bf16_t* base = O + (size_t)u.sub * sub_stride; const int row0 = u.pm * BM + wr * 64 + fr, col0 = u.pn * BM + wc * 32 + 8 * fq;
#pragma unroll
        EPI_ROWLOOP { bf16_t* rowp = base + (size_t)(row0 + ai * HALF + m * 16) * ldc + col0;
#pragma unroll
            for (int bj = 0; bj < 2; ++bj) { const f32x4 v0 = acc[ai][bj][m][0] * scale, v1 = acc[ai][bj][m][1] * scale; u32x4 w;
                w.x = cvt_pk_bf16(v0[0], v0[1]); w.y = cvt_pk_bf16(v0[2], v0[3]); w.z = cvt_pk_bf16(v1[0], v1[1]); w.w = cvt_pk_bf16(v1[2], v1[3]); *(u32x4*)(rowp + bj * HALF) = w; } }
    }
};
struct EpiBf16R {
    static constexpr bool PERM = true, AFTER_DRAIN = false;
    bf16_t* O; int ldc; float scale; const LAS float* rs;
    __device__ __forceinline__ void operator()(AccT acc, const Unit& u, int wr, int wc, int fr, int fq) const {
        const int lr0 = wr * 64 + fr, row0 = u.pm * BM + lr0, col0 = u.pn * BM + wc * 32 + 8 * fq;
#pragma unroll
        EPI_ROWLOOP { bf16_t* rowp = O + (size_t)(row0 + ai * HALF + m * 16) * ldc + col0; const float sc = scale * rs[lr0 + ai * HALF + m * 16];
#pragma unroll
            for (int bj = 0; bj < 2; ++bj) { const f32x4 v0 = acc[ai][bj][m][0] * sc, v1 = acc[ai][bj][m][1] * sc; u32x4 w;
                w.x = cvt_pk_bf16(v0[0], v0[1]); w.y = cvt_pk_bf16(v0[2], v0[3]); w.z = cvt_pk_bf16(v1[0], v1[1]); w.w = cvt_pk_bf16(v1[2], v1[3]); *(u32x4*)(rowp + bj * HALF) = w; } }
    }
};
struct EpiConvIn {
    static constexpr bool PERM = true, AFTER_DRAIN = false;
    bf16_t* U; bf16_t* BG;
    __device__ __forceinline__ void operator()(AccT acc, const Unit& u, int wr, int wc, int fr, int fq) const {
        const int row0 = u.pm * BM + wr * 64 + fr, cw = wc * 32 + 8 * fq;
        if (u.pn < 8) {
#pragma unroll
            EPI_ROWLOOP { bf16_t* rowp = U + (size_t)(row0 + ai * HALF + m * 16) * D + u.pn * 128 + cw; const f32x4 v0 = acc[ai][0][m][0] * acc[ai][1][m][0], v1 = acc[ai][0][m][1] * acc[ai][1][m][1]; u32x4 w;
                w.x = cvt_pk_bf16(v0[0], v0[1]); w.y = cvt_pk_bf16(v0[2], v0[3]); w.z = cvt_pk_bf16(v1[0], v1[1]); w.w = cvt_pk_bf16(v1[2], v1[3]); *(u32x4*)rowp = w; }
        } else {
#pragma unroll
            EPI_ROWLOOP { bf16_t* rowp = BG + (size_t)(row0 + ai * HALF + m * 16) * D + (u.pn - 8) * 256 + cw;
#pragma unroll
                for (int bj = 0; bj < 2; ++bj) { const f32x4 v0 = acc[ai][bj][m][0], v1 = acc[ai][bj][m][1]; u32x4 w;
                    w.x = cvt_pk_bf16(v0[0], v0[1]); w.y = cvt_pk_bf16(v0[2], v0[3]); w.z = cvt_pk_bf16(v1[0], v1[1]); w.w = cvt_pk_bf16(v1[2], v1[3]); *(u32x4*)(rowp + bj * HALF) = w; } }
        }
    }
};
struct EpiSwiGLU {
    static constexpr bool PERM = true, AFTER_DRAIN = false;
    bf16_t* H;
    __device__ __forceinline__ void operator()(AccT acc, const Unit& u, int wr, int wc, int fr, int fq) const {
        const int row0 = u.pm * BM + wr * 64 + fr, cw = u.pn * 128 + wc * 32 + 8 * fq;
#pragma unroll
        EPI_ROWLOOP { bf16_t* rowp = H + (size_t)(row0 + ai * HALF + m * 16) * 1024 + cw; float o[8];
#pragma unroll
            for (int n = 0; n < 2; ++n)
#pragma unroll
                for (int j = 0; j < 4; ++j) { const float g = acc[ai][0][m][n][j], up = acc[ai][1][m][n][j]; o[n * 4 + j] = g * sigmoidf_(g) * up; }
            u32x4 w; w.x = cvt_pk_bf16(o[0], o[1]); w.y = cvt_pk_bf16(o[2], o[3]); w.z = cvt_pk_bf16(o[4], o[5]); w.w = cvt_pk_bf16(o[6], o[7]); *(u32x4*)rowp = w; }
    }
};
struct EpiSwiGLU8 {
    static constexpr bool PERM = true, AFTER_DRAIN = false;
    unsigned char* H;
    __device__ __forceinline__ void operator()(AccT acc, const Unit& u, int wr, int wc, int fr, int fq) const {
        const int row0 = u.pm * BM + wr * 64 + fr, cw = u.pn * 128 + wc * 32 + 8 * fq; constexpr float inv = 1.f / (FP8_SX * FP8_SW);
#pragma unroll
        EPI_ROWLOOP { unsigned char* rowp = H + (size_t)(row0 + ai * HALF + m * 16) * 1024 + cw; float o[8];
#pragma unroll
            for (int n = 0; n < 2; ++n)
#pragma unroll
                for (int j = 0; j < 4; ++j) { const float g = acc[ai][0][m][n][j] * inv, up = acc[ai][1][m][n][j] * (inv * FP8_SH); o[n * 4 + j] = g * sigmoidf_(g) * up; }
            u32x2 w; w.x = pk_fp8x4(o[0], o[1], o[2], o[3]); w.y = pk_fp8x4(o[4], o[5], o[6], o[7]); *(u32x2*)rowp = w; }
    }
};
struct EpiDown {
    static constexpr bool PERM = true, AFTER_DRAIN = false;
    bf16_t* Y; const float* aff; float post;
    __device__ __forceinline__ void operator()(AccT acc, const Unit& u, int wr, int wc, int fr, int fq) const {
        const int row0 = u.pm * BM + wr * 64 + fr, col0 = u.pn * BM + wc * 32 + 8 * fq;
#pragma unroll
        EPI_ROWLOOP { const int row = row0 + ai * HALF + m * 16; const float s = aff[row] * post; bf16_t* rowp = Y + (size_t)row * 1024 + col0;
#pragma unroll
            for (int bj = 0; bj < 2; ++bj) { const f32x4 v0 = acc[ai][bj][m][0] * s, v1 = acc[ai][bj][m][1] * s; u32x4 w;
                w.x = cvt_pk_bf16(v0[0], v0[1]); w.y = cvt_pk_bf16(v0[2], v0[3]); w.z = cvt_pk_bf16(v1[0], v1[1]); w.w = cvt_pk_bf16(v1[2], v1[3]); *(u32x4*)(rowp + bj * HALF) = w; } }
    }
};
template <bool BASEF32, bool SSQ = false>
struct EpiResidualT {
    static constexpr bool PERM = true, AFTER_DRAIN = false;
    const void* base; bf16_t* out; float* ssq;
    __device__ __forceinline__ void operator()(AccT acc, const Unit& u, int wr, int wc, int fr, int fq) const {
        const int row0 = u.pm * BM + wr * 64 + fr, col0 = u.pn * BM + wc * 32 + 8 * fq;
#pragma unroll
        EPI_ROWLOOP { const int row = row0 + ai * HALF + m * 16; const size_t off = (size_t)row * D + col0; float sq = 0.f;
#pragma unroll
            for (int bj = 0; bj < 2; ++bj) { f32x4 v0 = acc[ai][bj][m][0], v1 = acc[ai][bj][m][1];
                if constexpr (BASEF32) { const float* bp = (const float*)base + off + bj * HALF; v0 += *(const f32x4*)bp; v1 += *(const f32x4*)(bp + 4); }
                else { const u32x4 b = *(const u32x4*)((const bf16_t*)base + off + bj * HALF); v0[0] += bf_lo(b.x); v0[1] += bf_hi(b.x); v0[2] += bf_lo(b.y); v0[3] += bf_hi(b.y); v1[0] += bf_lo(b.z); v1[1] += bf_hi(b.z); v1[2] += bf_lo(b.w); v1[3] += bf_hi(b.w); }
                if constexpr (SSQ) sq += ((v0[0] * v0[0] + v0[1] * v0[1]) + (v0[2] * v0[2] + v0[3] * v0[3])) + ((v1[0] * v1[0] + v1[1] * v1[1]) + (v1[2] * v1[2] + v1[3] * v1[3]));
                u32x4 w; w.x = cvt_pk_bf16(v0[0], v0[1]); w.y = cvt_pk_bf16(v0[2], v0[3]); w.z = cvt_pk_bf16(v1[0], v1[1]); w.w = cvt_pk_bf16(v1[2], v1[3]); *(u32x4*)(out + off + bj * HALF) = w; }
            if constexpr (SSQ) { sq += __shfl_xor(sq, 16); sq += __shfl_xor(sq, 32); if (fq == 0) ssq[(size_t)row * 16 + u.pn * 4 + wc] = sq; } }
    }
};
typedef EpiResidualT<false> EpiResidual;
struct EpiF32 {
    static constexpr bool PERM = false, AFTER_DRAIN = false;
    float* out; size_t sub_stride;
    __device__ __forceinline__ void operator()(AccT acc, const Unit& u, int wr, int wc, int fr, int fq) const {
        float* o = out + (size_t)u.sub * sub_stride; const int row0 = u.pm * BM + wr * 64 + fr, col0 = u.pn * BM + wc * 32 + 4 * fq;
#pragma unroll
        EPI_ROWLOOP { const size_t off = (size_t)(row0 + ai * HALF + m * 16) * D + col0;
#pragma unroll
            for (int bj = 0; bj < 2; ++bj)
#pragma unroll
                for (int n = 0; n < 2; ++n) *(f32x4*)(o + off + bj * HALF + n * 16) = acc[ai][bj][m][n]; }
    }
};
struct EpiLora1 {
    static constexpr bool PERM = true, AFTER_DRAIN = false;
    bf16_t* out;
    __device__ __forceinline__ void operator()(AccT acc, const Unit& u, int wr, int wc, int fr, int fq) const {
        bf16_t* o = out + (size_t)u.sub * ((size_t)T * 128); const int row0 = u.pm * BM + wr * 64 + fr, cw = wc * 32 + 8 * fq;
#pragma unroll
        EPI_ROWLOOP { float v[8];
#pragma unroll
            for (int n = 0; n < 2; ++n)
#pragma unroll
                for (int j = 0; j < 4; ++j) { float x = acc[ai][0][m][n][j];
                    if (u.sub == 0) x = 1.f - 2.f * __builtin_amdgcn_rcpf(1.f + __expf(2.f * x)); else if (u.sub == 2) x = sigmoidf_(x);
                    v[n * 4 + j] = x; }
            u32x4 w; w.x = cvt_pk_bf16(v[0], v[1]); w.y = cvt_pk_bf16(v[2], v[3]); w.z = cvt_pk_bf16(v[4], v[5]); w.w = cvt_pk_bf16(v[6], v[7]);
            *(u32x4*)(o + (size_t)(row0 + ai * HALF + m * 16) * 128 + cw) = w; }
    }
};
struct EpiLora2 {
    static constexpr bool PERM = true, AFTER_DRAIN = false;
    bf16_t* logw; bf16_t* iclr; bf16_t* gate; const float* w0; const float* a0;
    __device__ __forceinline__ void operator()(AccT acc, const Unit& u, int wr, int wc, int fr, int fq) const {
        const int row0 = u.pm * BM + wr * 64 + fr, col0 = u.pn * BM + wc * 32 + 8 * fq; const int kind = u.sub % 3, dir = u.sub / 3;
        if (kind == 0) {
            bf16_t* o = logw + (size_t)dir * T * D; const float* bp = w0 + dir * D + col0;
#pragma unroll
            for (int bj = 0; bj < 2; ++bj) { const f32x4 b0 = *(const f32x4*)(bp + bj * HALF), b1 = *(const f32x4*)(bp + bj * HALF + 4); __builtin_amdgcn_sched_barrier(0);
#pragma unroll
                for (int ai = 0; ai < 2; ++ai)
#pragma unroll
                    for (int m = 0; m < 4; ++m) { const f32x4 x = acc[ai][bj][m][0] + b0, y = acc[ai][bj][m][1] + b1; u32x4 w;
                        w.x = cvt_pk_bf16(-0.6065306597126334f * sigmoidf_(x[0]), -0.6065306597126334f * sigmoidf_(x[1])); w.y = cvt_pk_bf16(-0.6065306597126334f * sigmoidf_(x[2]), -0.6065306597126334f * sigmoidf_(x[3])); __builtin_amdgcn_sched_barrier(0);
                        w.z = cvt_pk_bf16(-0.6065306597126334f * sigmoidf_(y[0]), -0.6065306597126334f * sigmoidf_(y[1])); w.w = cvt_pk_bf16(-0.6065306597126334f * sigmoidf_(y[2]), -0.6065306597126334f * sigmoidf_(y[3]));
                        *(u32x4*)(o + (size_t)(row0 + ai * HALF + m * 16) * D + col0 + bj * HALF) = w; __builtin_amdgcn_sched_barrier(0); } }
        } else if (kind == 1) {
            bf16_t* o = iclr + (size_t)dir * T * D; const float* bp = a0 + dir * D + col0;
#pragma unroll
            for (int bj = 0; bj < 2; ++bj) { const f32x4 b0 = *(const f32x4*)(bp + bj * HALF), b1 = *(const f32x4*)(bp + bj * HALF + 4); __builtin_amdgcn_sched_barrier(0);
#pragma unroll
                for (int ai = 0; ai < 2; ++ai)
#pragma unroll
                    for (int m = 0; m < 4; ++m) { const f32x4 x = acc[ai][bj][m][0] + b0, y = acc[ai][bj][m][1] + b1; u32x4 w;
                        w.x = cvt_pk_bf16(sigmoidf_(x[0]), sigmoidf_(x[1])); w.y = cvt_pk_bf16(sigmoidf_(x[2]), sigmoidf_(x[3])); __builtin_amdgcn_sched_barrier(0); w.z = cvt_pk_bf16(sigmoidf_(y[0]), sigmoidf_(y[1])); w.w = cvt_pk_bf16(sigmoidf_(y[2]), sigmoidf_(y[3]));
                        *(u32x4*)(o + (size_t)(row0 + ai * HALF + m * 16) * D + col0 + bj * HALF) = w; __builtin_amdgcn_sched_barrier(0); } }
        } else {
#pragma unroll
            for (int bj = 0; bj < 2; ++bj)
#pragma unroll
                for (int ai = 0; ai < 2; ++ai)
#pragma unroll
                    for (int m = 0; m < 4; ++m) { const f32x4 x = acc[ai][bj][m][0], y = acc[ai][bj][m][1]; u32x4 w; w.x = cvt_pk_bf16(x[0], x[1]); w.y = cvt_pk_bf16(x[2], x[3]); w.z = cvt_pk_bf16(y[0], y[1]); w.w = cvt_pk_bf16(y[2], y[3]);
                        *(u32x4*)(gate + (size_t)(row0 + ai * HALF + m * 16) * D + col0 + bj * HALF) = w; __builtin_amdgcn_sched_barrier(0); }
        }
    }
};
struct EpiSoftmax {
    static constexpr bool PERM = true, AFTER_DRAIN = true;
    bf16_t* P; const LAS float* rs; float scale;
    __device__ __forceinline__ void fused(f32x4 (&acc)[2][2][4][2], const Unit& u, int wr, int wc, int fr, int fq, LAS unsigned char* lds, int wid, int lane) const {
        LAS float* X1 = (LAS float*)lds;
        LAS float* X2 = (LAS float*)(lds + 4096);
        float mx[2][4];
#pragma unroll
        EPI_ROWLOOP { const float sc = scale * rs[ai * HALF + wr * 64 + m * 16 + fr];
#pragma unroll
            for (int bj = 0; bj < 2; ++bj)
#pragma unroll
                for (int n = 0; n < 2; ++n) acc[ai][bj][m][n] = acc[ai][bj][m][n] * sc; }
#pragma unroll
        EPI_ROWLOOP { float v = -3.0e38f;
#pragma unroll
            for (int bj = 0; bj < 2; ++bj)
#pragma unroll
                for (int n = 0; n < 2; ++n)
#pragma unroll
                    for (int j = 0; j < 4; ++j) v = fmaxf(v, acc[ai][bj][m][n][j]);
            v = fmaxf(v, __shfl_xor(v, 16)); v = fmaxf(v, __shfl_xor(v, 32));
            if (fq == 0) X1[(ai * HALF + wr * 64 + m * 16 + fr) * 4 + wc] = v; }
        asm volatile("s_waitcnt lgkmcnt(0)" ::: "memory"); __builtin_amdgcn_s_barrier(); asm volatile("" ::: "memory");
#pragma unroll
        EPI_ROWLOOP { const f32x4 p = *(const LAS f32x4*)(X1 + (ai * HALF + wr * 64 + m * 16 + fr) * 4); mx[ai][m] = fmaxf(fmaxf(p[0], p[1]), fmaxf(p[2], p[3])); }
#pragma unroll
        EPI_ROWLOOP { float s = 0.f;
#pragma unroll
            for (int bj = 0; bj < 2; ++bj)
#pragma unroll
                for (int n = 0; n < 2; ++n)
#pragma unroll
                    for (int j = 0; j < 4; ++j) { const float e = __builtin_amdgcn_exp2f(acc[ai][bj][m][n][j] - mx[ai][m]); acc[ai][bj][m][n][j] = e; s += e; }
            s += __shfl_xor(s, 16); s += __shfl_xor(s, 32);
            if (fq == 0) X2[(ai * HALF + wr * 64 + m * 16 + fr) * 4 + wc] = s; }
        asm volatile("s_waitcnt lgkmcnt(0)" ::: "memory"); __builtin_amdgcn_s_barrier(); asm volatile("" ::: "memory");
        const int row0 = u.pm * BM + wr * 64 + fr, col0 = u.pn * BM + wc * 32 + 8 * fq;
#pragma unroll
        EPI_ROWLOOP { const f32x4 p = *(const LAS f32x4*)(X2 + (ai * HALF + wr * 64 + m * 16 + fr) * 4); const float inv = __builtin_amdgcn_rcpf((p[0] + p[1]) + (p[2] + p[3]));
            bf16_t* rowp = P + (size_t)(row0 + ai * HALF + m * 16) * 1024 + col0;
#pragma unroll
            for (int bj = 0; bj < 2; ++bj) { const f32x4 v0 = acc[ai][bj][m][0] * inv, v1 = acc[ai][bj][m][1] * inv; u32x4 w;
                w.x = cvt_pk_bf16(v0[0], v0[1]); w.y = cvt_pk_bf16(v0[2], v0[3]); w.z = cvt_pk_bf16(v1[0], v1[1]); w.w = cvt_pk_bf16(v1[2], v1[3]); *(u32x4*)(rowp + bj * HALF) = w; } }
        asm volatile("s_waitcnt lgkmcnt(0)" ::: "memory"); __builtin_amdgcn_s_barrier(); asm volatile("" ::: "memory");
    }
};
}

#define XB_TMO      128
#define XB_XCNT(j)  (256  + 64 * (j))
#define XB_XSUB(j)  (1280 + 64 * (j))
#define XB_XGEN(j)  (2304 + 64 * (j))
#define XB_TOP      3328
#define XB_TOPGEN   3392
#define XCD_BAR_WORDS 3456
#define XB_SPIN_CAP (1u << 22)
__device__ __forceinline__ unsigned xb_ld(unsigned* p)              { return __hip_atomic_load(p, __ATOMIC_RELAXED, __HIP_MEMORY_SCOPE_AGENT); }
__device__ __forceinline__ unsigned xb_add(unsigned* p, unsigned v) { return __hip_atomic_fetch_add(p, v, __ATOMIC_RELAXED, __HIP_MEMORY_SCOPE_AGENT); }
__device__ __forceinline__ unsigned xb_xcc_id() { return (unsigned)__builtin_amdgcn_s_getreg((3 << 11) | 20) & 0xFu; }
#define XB_SPIN(cond, bar) do { unsigned _sp = 0; while (cond) { __builtin_amdgcn_s_sleep(1); \
    if ((++_sp & 255u) == 0u) { if (xb_ld(&(bar)[XB_TMO])) break; if (_sp > XB_SPIN_CAP) { atomicAdd(&(bar)[XB_TMO], 1u); break; } } } } while (0)
struct XcdBarrier { unsigned* bar; unsigned x; volatile LAS unsigned* st; };
__device__ __forceinline__ XcdBarrier xcd_barrier_post(unsigned* bar, volatile LAS unsigned* st) {
    XcdBarrier b; b.bar = bar; b.x = xb_xcc_id(); b.st = st;
    if (threadIdx.x == 0) (void)xb_add(&bar[XB_XCNT(b.x)], 1u);
    return b;
}
__device__ __forceinline__ void xcd_barrier_complete(unsigned* bar, unsigned x, unsigned& nloc, unsigned& nx) {
    const unsigned G = gridDim.x * gridDim.y * gridDim.z;
    unsigned sum, cnt, mine, sp = 0u;
    for (;;) {
        sum = 0u; cnt = 0u; mine = 0u;
#pragma unroll
        for (unsigned j = 0; j < 16; ++j) { const unsigned c = xb_ld(&bar[XB_XCNT(j)]); sum += c; cnt += (c > 0u) ? 1u : 0u; mine = (j == x) ? c : mine; }
        if (sum == G) break;
        __builtin_amdgcn_s_sleep(1);
        if ((++sp & 255u) == 0u) { if (xb_ld(&bar[XB_TMO])) break; if (sp > XB_SPIN_CAP) { atomicAdd(&bar[XB_TMO], 1u); break; } }
    }
    nloc = mine > 0u ? mine : 1u; nx = cnt > 0u ? cnt : 1u;
}
__device__ __forceinline__ void xcd_barrier(const XcdBarrier& b) {
    asm volatile("s_waitcnt vmcnt(0)" ::: "memory");
    __syncthreads();
    if (threadIdx.x == 0) {
        unsigned* bar = b.bar; asm volatile("" : "+v"(bar));
        __builtin_amdgcn_s_waitcnt(0);
        unsigned nloc = b.st[0], nx = b.st[1];
        if (nloc == 0u) { xcd_barrier_complete(bar, b.x, nloc, nx); b.st[0] = nloc; b.st[1] = nx; }
        const unsigned old = xb_add(&bar[XB_XSUB(b.x)], 1u);
        const unsigned gen = old / nloc;
        if (old + 1u == (gen + 1u) * nloc) {
            __builtin_amdgcn_fence(__ATOMIC_RELEASE, "agent");
            asm volatile("s_waitcnt vmcnt(0)" ::: "memory");
            const unsigned og = xb_add(&bar[XB_TOP], 1u);
            const unsigned tg = og / nx;
            if (og + 1u == (tg + 1u) * nx) xb_add(&bar[XB_TOPGEN], 1u);
            else XB_SPIN(xb_ld(&bar[XB_TOPGEN]) == tg, bar);
            __builtin_amdgcn_fence(__ATOMIC_ACQUIRE, "agent");
            xb_add(&bar[XB_XGEN(b.x)], 1u);
            asm volatile("s_waitcnt vmcnt(0)" ::: "memory");
        } else {
            XB_SPIN(xb_ld(&bar[XB_XGEN(b.x)]) == gen, bar);
            __builtin_amdgcn_fence(__ATOMIC_ACQUIRE, "agent");
            asm volatile("s_waitcnt vmcnt(0)" ::: "memory");
        }
    }
    __syncthreads();
}

struct Args { const float* in[34]; float* out; unsigned char* ws; int ph_lo, ph_hi, dbg, pad; };
struct Frame {
    LAS unsigned char* lds;
    int tid, lane, wave, G, gw, NGW;
    unsigned char* ws;
};
__device__ __forceinline__ const float* inp(const struct Args& a, int k);
enum { I_X = 0, I_MEM, I_NMIX, I_NXATTN, I_NMEM, I_NFFN, I_NFINAL, I_CONV_WIN, I_CONV_W, I_CONV_WOUT, I_MU, I_WRKV, I_W0, I_W1, I_W2, I_A0, I_A1, I_A2, I_G1, I_G2,
       I_KK, I_KA, I_RK, I_LNW, I_LNB, I_RWOUT, I_XWQ, I_XWKV, I_XWO, I_ROUTER, I_WGATE, I_WUP, I_WDOWN, I_WS };

__device__ __forceinline__ const float* inp(const Args& a, int k) { asm volatile("" : "+s"(k)); return a.in[k]; }
__device__ __forceinline__ void convert_item(const float* src, int ld_src, int k0, int n0, bf16_t* dst, int ld_dst, int drow0, int dk0, LAS float* scr, int lane, const float* gk = nullptr) {
    { f32x4 t[8]; const int kq = lane >> 3, nq = 4 * (lane & 7);
#pragma unroll
        for (int i = 0; i < 8; ++i) t[i] = __builtin_nontemporal_load((const f32x4*)(src + (size_t)(k0 + 8 * i + kq) * ld_src + n0 + nq));
        if (gk) {
#pragma unroll
            for (int i = 0; i < 8; ++i) t[i] = t[i] * gk[k0 + 8 * i + kq]; }
#pragma unroll
        for (int i = 0; i < 8; ++i) { LAS float* d = scr + (8 * i + kq) * 33 + nq; d[0] = t[i][0]; d[1] = t[i][1]; d[2] = t[i][2]; d[3] = t[i][3]; } }
    LDS_WAIT(); asm volatile("" ::: "memory");
    const int c = lane & 7;
#pragma unroll
    for (int j = 0; j < 4; ++j) { const int n = (lane >> 3) + 8 * j; const LAS float* s = scr + (8 * c) * 33 + n;
        u32x4 o; o.x = pk2(s[0 * 33], s[1 * 33]); o.y = pk2(s[2 * 33], s[3 * 33]); o.z = pk2(s[4 * 33], s[5 * 33]); o.w = pk2(s[6 * 33], s[7 * 33]);
        *(u32x4*)(dst + (size_t)(drow0 + n) * ld_dst + dk0 + k0 + 8 * c) = o; }
    LDS_WAIT(); asm volatile("" ::: "memory");
}
__device__ __forceinline__ void convert_item8(const float* src, int ld_src, int k0, int n0, unsigned char* dst, int ld_dst, int drow0, float scale, LAS float* scr, int lane, const float* gk = nullptr) {
    { f32x4 t[8]; const int kq = lane >> 3, nq = 4 * (lane & 7);
#pragma unroll
        for (int i = 0; i < 8; ++i) t[i] = __builtin_nontemporal_load((const f32x4*)(src + (size_t)(k0 + 8 * i + kq) * ld_src + n0 + nq));
        if (gk) {
#pragma unroll
            for (int i = 0; i < 8; ++i) t[i] = t[i] * gk[k0 + 8 * i + kq]; }
#pragma unroll
        for (int i = 0; i < 8; ++i) { LAS float* d = scr + (8 * i + kq) * 33 + nq; d[0] = t[i][0]; d[1] = t[i][1]; d[2] = t[i][2]; d[3] = t[i][3]; } }
    LDS_WAIT(); asm volatile("" ::: "memory");
    const int n = lane & 31, hf = lane >> 5; const LAS float* s = scr + (32 * hf) * 33 + n;
    unsigned char* d = dst + (size_t)(drow0 + n) * ld_dst + k0 + 32 * hf;
#pragma unroll
    for (int q = 0; q < 2; ++q) { u32x4 o;
        o.x = pk_fp8x4(s[(16 * q + 0) * 33] * scale, s[(16 * q + 1) * 33] * scale, s[(16 * q + 2) * 33] * scale, s[(16 * q + 3) * 33] * scale);
        o.y = pk_fp8x4(s[(16 * q + 4) * 33] * scale, s[(16 * q + 5) * 33] * scale, s[(16 * q + 6) * 33] * scale, s[(16 * q + 7) * 33] * scale);
        o.z = pk_fp8x4(s[(16 * q + 8) * 33] * scale, s[(16 * q + 9) * 33] * scale, s[(16 * q + 10) * 33] * scale, s[(16 * q + 11) * 33] * scale);
        o.w = pk_fp8x4(s[(16 * q + 12) * 33] * scale, s[(16 * q + 13) * 33] * scale, s[(16 * q + 14) * 33] * scale, s[(16 * q + 15) * 33] * scale);
        *(u32x4*)(d + 16 * q) = o; }
    LDS_WAIT(); asm volatile("" ::: "memory");
}
template <int MAP>
__device__ __forceinline__ void convert_matrix(const Frame& F, LAS float* scr, const float* src, int ld_src, int K, int N, bf16_t* dst, int ld_dst, int drow_base, int dk0) {
    const int nnb = N / 32, nitems = (K / 64) * nnb;
    for (int it = F.gw; it < nitems; it += F.NGW) { const int kb = it / nnb, nb = it - kb * nnb, n0 = nb * 32;
        const int drow = MAP == 0 ? drow_base + n0 : (n0 / 128) * 256 + (n0 % 128) + drow_base;
        convert_item(src, ld_src, kb * 64, n0, dst, ld_dst, drow, dk0, scr, F.lane); }
}
__device__ __forceinline__ void zero_region(const Frame& F, bf16_t* dst, int ld, int r0, int nr, int k0, int nk) {
    const int per = nk / 8, total = nr * per; const int gt = F.gw * 64 + F.lane, NT = F.NGW * 64;
    for (int i = gt; i < total; i += NT) { const int r = i / per, c = i - r * per; *(u32x4*)(dst + (size_t)(r0 + r) * ld + k0 + c * 8) = (u32x4){0u, 0u, 0u, 0u}; }
}

__device__ __forceinline__ void row_load(const float* p, int lane, f32x4 (&v)[4]) {
#pragma unroll
    for (int j = 0; j < 4; ++j) v[j] = *(const f32x4*)(p + 4 * lane + 256 * j);
}
__device__ __forceinline__ void row_store_f32(float* p, int lane, const f32x4 (&v)[4]) {
#pragma unroll
    for (int j = 0; j < 4; ++j) *(f32x4*)(p + 4 * lane + 256 * j) = v[j];
}
__device__ __forceinline__ void row_store_bf16(bf16_t* p, int lane, const f32x4 (&v)[4]) {
#pragma unroll
    for (int j = 0; j < 4; ++j) { u32x2 w; w.x = pk2(v[j][0], v[j][1]); w.y = pk2(v[j][2], v[j][3]); __builtin_nontemporal_store(w, (u32x2*)(p + 4 * lane + 256 * j)); }
}
__device__ __forceinline__ void row_store_fp8(unsigned char* p, int lane, const f32x4 (&v)[4], float scale) {
#pragma unroll
    for (int j = 0; j < 4; ++j) __builtin_nontemporal_store(pk_fp8x4(v[j][0] * scale, v[j][1] * scale, v[j][2] * scale, v[j][3] * scale), (unsigned*)(p + 4 * lane + 256 * j));
}
__device__ __forceinline__ void row_load_b16(const bf16_t* p, int lane, f32x4 (&v)[4]) {
#pragma unroll
    for (int j = 0; j < 4; ++j) { const u32x2 w = *(const u32x2*)(p + 4 * lane + 256 * j); v[j][0] = bf_lo(w.x); v[j][1] = bf_hi(w.x); v[j][2] = bf_lo(w.y); v[j][3] = bf_hi(w.y); }
}
__device__ __forceinline__ void row_load_bf16_add(const bf16_t* p, int lane, f32x4 (&v)[4]) {
#pragma unroll
    for (int j = 0; j < 4; ++j) { const u32x2 w = *(const u32x2*)(p + 4 * lane + 256 * j); v[j][0] += bf_lo(w.x); v[j][1] += bf_hi(w.x); v[j][2] += bf_lo(w.y); v[j][3] += bf_hi(w.y); }
}
__device__ __forceinline__ float row_sumsq(const f32x4 (&v)[4]) {
    float s = 0.f;
#pragma unroll
    for (int j = 0; j < 4; ++j) s += (v[j][0] * v[j][0] + v[j][1] * v[j][1]) + (v[j][2] * v[j][2] + v[j][3] * v[j][3]);
    return wave_sum(s);
}
__device__ __forceinline__ void row_rmsnorm(f32x4 (&v)[4], const float* g, int lane) {
    const float r = __builtin_amdgcn_rsqf(row_sumsq(v) * (1.f / D) + RMS_EPS);
#pragma unroll
    for (int j = 0; j < 4; ++j) { const f32x4 gg = *(const f32x4*)(g + 4 * lane + 256 * j); v[j] = v[j] * r * gg; }
}
template <bool COMBINE>
__device__ __forceinline__ void row_fetch(const bf16_t* Hin, const bf16_t* YE, const int* SLOT, int m, int lane, f32x4 (&v)[4]) {
    row_load_b16(Hin + (size_t)m * D, lane, v);
    if (COMBINE) {
        const int b = m / SEQ, t = m - b * SEQ;
        const int sl = (lane < NE) ? SLOT[((size_t)b * NE + lane) * SEQ + t] : -1;
        unsigned long long mask = __ballot(sl >= 0);
        while (mask) {
            const int e0 = __builtin_ctzll(mask); mask &= mask - 1; const int s0 = __shfl(sl, e0);
            const bf16_t* p0 = YE + ((size_t)(e0 * NB + b) * CAP + s0) * D;
            if (mask) { const int e1 = __builtin_ctzll(mask); mask &= mask - 1; const int s1 = __shfl(sl, e1);
                const bf16_t* p1 = YE + ((size_t)(e1 * NB + b) * CAP + s1) * D; u32x2 w0[4], w1[4];
#pragma unroll
                for (int j = 0; j < 4; ++j) { w0[j] = *(const u32x2*)(p0 + 4 * lane + 256 * j); w1[j] = *(const u32x2*)(p1 + 4 * lane + 256 * j); }
#pragma unroll
                for (int j = 0; j < 4; ++j) { v[j][0] += bf_lo(w0[j].x) + bf_lo(w1[j].x); v[j][1] += bf_hi(w0[j].x) + bf_hi(w1[j].x); v[j][2] += bf_lo(w0[j].y) + bf_lo(w1[j].y); v[j][3] += bf_hi(w0[j].y) + bf_hi(w1[j].y); }
            } else row_load_bf16_add(p0, lane, v);
        }
    }
}

struct CJob { int in_idx, src_off, ld_src, K, N, dst_off, ld_dst, drow, dk0, map, first, g_idx, g_off; };
struct CJobTable { CJob j[64]; int n, total; };
constexpr CJobTable make_cjobs() {
    CJobTable t{}; int n = 0, tot = 0;
    auto add = [&](int in_idx, size_t src_off, int ld_src, int K, int N, size_t dst_bytes, int ld_dst, int drow, int dk0, int map, int g_idx = -1, int g_off = 0) {
        t.j[n] = CJob{in_idx, (int)src_off, ld_src, K, N, (int)(dst_bytes - WS_W), ld_dst, drow, dk0, map, tot, g_idx, g_off}; tot += (K / 64) * (N / 32); ++n; };
    for (int j = 0; j < 2; ++j) {
        add(I_CONV_WIN, (size_t)j * 1024 * 3072, 3072, 1024, 1024, WS_CONVIN + j * SZ_CONVIN, 1024, 2048, 0, 0);
        add(I_CONV_WIN, (size_t)j * 1024 * 3072 + 1024, 3072, 1024, 1024, WS_CONVIN + j * SZ_CONVIN, 1024, 0, 0, 1);
        add(I_CONV_WIN, (size_t)j * 1024 * 3072 + 2048, 3072, 1024, 1024, WS_CONVIN + j * SZ_CONVIN, 1024, 128, 0, 1);
        add(I_CONV_WOUT, (size_t)j * 1024 * 1024, 1024, 1024, 1024, WS_CONVOUT + j * SZ_SQ, 1024, 0, 0, 0);
    }
    for (int j = 0; j < 2; ++j) {
        for (int q = 0; q < 3; ++q) add(I_WRKV, (size_t)(j * 3 + q) * 1024 * 1024, 1024, 1024, 1024, WS_RKV + (j * 3 + q) * SZ_SQ, 1024, 0, 0, 0);
        for (int dir = 0; dir < 2; ++dir) {
            add(I_W1, (size_t)(j * 2 + dir) * 1024 * 64, 64, 1024, 64, WS_L1 + j * SZ_L1, 1024, dir * 64, 0, 0);
            add(I_A1, (size_t)(j * 2 + dir) * 1024 * 64, 64, 1024, 64, WS_L1 + j * SZ_L1, 1024, 256 + dir * 64, 0, 0);
            add(I_W2, (size_t)(j * 2 + dir) * 64 * 1024, 1024, 64, 1024, WS_L2 + j * SZ_L2 + (size_t)(dir * 3 + 0) * 1024 * 128 * 2, 128, 0, dir * 64, 0);
            add(I_A2, (size_t)(j * 2 + dir) * 64 * 1024, 1024, 64, 1024, WS_L2 + j * SZ_L2 + (size_t)(dir * 3 + 1) * 1024 * 128 * 2, 128, 0, dir * 64, 0);
        }
        add(I_G1, (size_t)j * 1024 * 128, 128, 1024, 128, WS_L1 + j * SZ_L1, 1024, 512, 0, 0);
        add(I_G2, (size_t)j * 128 * 1024, 1024, 128, 1024, WS_L2 + j * SZ_L2 + (size_t)2 * 1024 * 128 * 2, 128, 0, 0, 0);
        add(I_RWOUT, (size_t)j * 1024 * 1024, 1024, 1024, 1024, WS_ROUT + j * SZ_SQ, 1024, 0, 0, 0);
    }
    for (int i = 0; i < 4; ++i) {
        add(I_XWKV, (size_t)i * 1024 * 2048, 2048, 1024, 2048, WS_WKV + i * 2 * SZ_SQ, 1024, 0, 0, 0);
        add(I_XWO, (size_t)i * 1024 * 1024, 1024, 1024, 1024, WS_WO + i * SZ_SQ, 1024, 0, 0, 0);
    }
    t.n = n; t.total = tot; return t;
}
__constant__ const CJobTable c_jobs = make_cjobs();
__device__ __forceinline__ void phase_prologue(const Frame& F, const Args& A) {
    LAS float* scr = (LAS float*)(F.lds + F.wave * 16384);
    unsigned char* ws = F.ws;
    for (int it = F.gw; it < c_jobs.total; it += F.NGW) {
        int jn = 0;
        for (int q = 1; q < c_jobs.n; ++q) jn = (it >= c_jobs.j[q].first) ? q : jn;
        const CJob jb = c_jobs.j[jn];
        const int li = it - jb.first, nnb = jb.N / 32, kb = li / nnb, nb = li - kb * nnb, n0 = nb * 32;
        const int drow = jb.map == 0 ? jb.drow + n0 : (n0 / 128) * 256 + (n0 % 128) + jb.drow;
        const float* gk = nullptr; if (jb.g_idx >= 0) gk = inp(A, jb.g_idx) + jb.g_off;
        convert_item(inp(A, jb.in_idx) + jb.src_off, jb.ld_src, kb * 64, n0, (bf16_t*)(ws + WS_W + jb.dst_off), jb.ld_dst, drow, jb.dk0, scr, F.lane, gk);
    }
    for (int j = 0; j < 2; ++j) {
        bf16_t* l1 = (bf16_t*)(ws + WS_L1 + j * SZ_L1);
        zero_region(F, l1, 1024, 128, 128, 0, 1024); zero_region(F, l1, 1024, 384, 128, 0, 1024); zero_region(F, l1, 1024, 640, 128, 0, 1024);
        bf16_t* l2 = (bf16_t*)(ws + WS_L2 + j * SZ_L2);
        for (int dir = 0; dir < 2; ++dir) { zero_region(F, l2 + (size_t)(dir * 3 + 0) * 1024 * 128, 128, 0, 1024, (1 - dir) * 64, 64); zero_region(F, l2 + (size_t)(dir * 3 + 1) * 1024 * 128, 128, 0, 1024, (1 - dir) * 64, 64); }
    }
    for (int idx = F.gw; idx < 4 * 1024; idx += F.NGW) { f32x4 v[4];
        row_load(inp(A, I_XWQ) + (size_t)idx * D, F.lane, v); const float gd = inp(A, I_NXATTN)[idx];
#pragma unroll
        for (int jj = 0; jj < 4; ++jj) v[jj] = v[jj] * gd;
        row_store_bf16((bf16_t*)(ws + WS_WQ) + (size_t)idx * D, F.lane, v); }
    for (int idx = F.gw; idx < 4 * 1024; idx += F.NGW) { const int l = idx >> 10, r = idx & 1023; f32x4 v[4];
        row_load(inp(A, I_MEM) + (size_t)r * D, F.lane, v); row_rmsnorm(v, inp(A, I_NMEM) + l * D, F.lane); row_store_bf16((bf16_t*)(ws + WS_MEMN) + (size_t)idx * D, F.lane, v); }
    for (int m = 2 * F.gw; m < T; m += 2 * F.NGW) { f32x4 v[4], w[4];
        row_load(inp(A, I_X) + (size_t)m * D, F.lane, v); row_load(inp(A, I_X) + (size_t)(m + 1) * D, F.lane, w); row_rmsnorm(v, inp(A, I_NMIX), F.lane); row_rmsnorm(w, inp(A, I_NMIX), F.lane);
        row_store_bf16((bf16_t*)(ws + WS_XN) + (size_t)m * D, F.lane, v); row_store_bf16((bf16_t*)(ws + WS_XN) + (size_t)(m + 1) * D, F.lane, w); }
}
__device__ __forceinline__ void moe_convert(const Frame& F, const Args& A, int i, int cgw, int CNGW) {
    LAS float* scr = (LAS float*)(F.lds + F.wave * 16384);
    const float* wg = inp(A, I_WGATE); const float* wu = inp(A, I_WUP); const float* wd = inp(A, I_WDOWN); const float* gf = inp(A, I_NFFN) + i * D;
    constexpr int NI = 4;
    const int lane = F.lane, kq = lane >> 3, nq = 4 * (lane & 7);
    for (int it = cgw; it < NE * 3 * 512; it += NI * CNGW) {
        const float* srcv[NI]; unsigned char* dstv[NI]; int k0v[NI], n0v[NI], drv[NI]; bool gv[NI]; f32x4 t[NI][8];
#pragma unroll
        for (int u = 0; u < NI; ++u) { const int x = (it + u * CNGW < NE * 3 * 512) ? it + u * CNGW : it;     const int e = x / 1536, r = x - e * 1536, mat = r >> 9, q = r & 511, kb = q >> 5, nb = q & 31, n0 = nb * 32;
            const size_t so = (size_t)(i * NE + e) * 1024 * 1024;
            srcv[u] = (mat == 0 ? wg : (mat == 1 ? wu : wd)) + so; gv[u] = mat < 2; k0v[u] = kb * 64; n0v[u] = n0;
            dstv[u] = mat < 2 ? F.ws + WS_WGU + (size_t)e * 2048 * 1024 : F.ws + WS_WD + (size_t)e * 1024 * 1024; drv[u] = mat < 2 ? (n0 / 128) * 256 + (n0 % 128) + mat * 128 : n0;
#pragma unroll
            for (int ii = 0; ii < 8; ++ii) t[u][ii] = __builtin_nontemporal_load((const f32x4*)(srcv[u] + (size_t)(k0v[u] + 8 * ii + kq) * 1024 + n0v[u] + nq)); }
#pragma unroll
        for (int u = 0; u < NI; ++u) {
            if (gv[u]) {
#pragma unroll
                for (int ii = 0; ii < 8; ++ii) t[u][ii] = t[u][ii] * gf[k0v[u] + 8 * ii + kq]; }
#pragma unroll
            for (int ii = 0; ii < 8; ++ii) { LAS float* d = scr + (8 * ii + kq) * 33 + nq; d[0] = t[u][ii][0]; d[1] = t[u][ii][1]; d[2] = t[u][ii][2]; d[3] = t[u][ii][3]; }
            LDS_WAIT(); asm volatile("" ::: "memory");
            const int n = lane & 31, hf = lane >> 5; const LAS float* sp = scr + (32 * hf) * 33 + n;
            unsigned char* d = dstv[u] + (size_t)(drv[u] + n) * 1024 + k0v[u] + 32 * hf;
#pragma unroll
            for (int q = 0; q < 2; ++q) { u32x4 o;
                o.x = pk_fp8x4(sp[(16 * q + 0) * 33] * FP8_SW, sp[(16 * q + 1) * 33] * FP8_SW, sp[(16 * q + 2) * 33] * FP8_SW, sp[(16 * q + 3) * 33] * FP8_SW);
                o.y = pk_fp8x4(sp[(16 * q + 4) * 33] * FP8_SW, sp[(16 * q + 5) * 33] * FP8_SW, sp[(16 * q + 6) * 33] * FP8_SW, sp[(16 * q + 7) * 33] * FP8_SW);
                o.z = pk_fp8x4(sp[(16 * q + 8) * 33] * FP8_SW, sp[(16 * q + 9) * 33] * FP8_SW, sp[(16 * q + 10) * 33] * FP8_SW, sp[(16 * q + 11) * 33] * FP8_SW);
                o.w = pk_fp8x4(sp[(16 * q + 12) * 33] * FP8_SW, sp[(16 * q + 13) * 33] * FP8_SW, sp[(16 * q + 14) * 33] * FP8_SW, sp[(16 * q + 15) * 33] * FP8_SW);
                *(u32x4*)(d + 16 * q) = o; }
            LDS_WAIT(); asm volatile("" ::: "memory");
        }
    }
}
__device__ __forceinline__ void phase_norm(const Frame& F, const bf16_t* H, const float* g, bf16_t* XN) {
    for (int m = 2 * F.gw; m < T; m += 2 * F.NGW) { f32x4 v[4], w[4]; row_load_b16(H + (size_t)m * D, F.lane, v); row_load_b16(H + (size_t)(m + 1) * D, F.lane, w);
        row_rmsnorm(v, g, F.lane); row_rmsnorm(w, g, F.lane); row_store_bf16(XN + (size_t)m * D, F.lane, v); row_store_bf16(XN + (size_t)(m + 1) * D, F.lane, w); }
}
template <int MODE>
__device__ __forceinline__ void phase_entry_plain(const Frame& F, const bf16_t* Hin, bf16_t* Hout, const bf16_t* YE, const int* SLOT, const float* g, bf16_t* XN, float* outf) {
    for (int m0 = 2 * F.gw; m0 < T; m0 += 2 * F.NGW) { f32x4 v[4], w[4]; row_fetch<true>(Hin, YE, SLOT, m0, F.lane, v); row_fetch<true>(Hin, YE, SLOT, m0 + 1, F.lane, w);
        if (MODE == 0) { row_store_bf16(Hout + (size_t)m0 * D, F.lane, v); row_store_bf16(Hout + (size_t)(m0 + 1) * D, F.lane, w); }
        row_rmsnorm(v, g, F.lane); row_rmsnorm(w, g, F.lane);
        if (MODE == 0) { row_store_bf16(XN + (size_t)m0 * D, F.lane, v); row_store_bf16(XN + (size_t)(m0 + 1) * D, F.lane, w); }
        else { row_store_f32(outf + (size_t)m0 * D, F.lane, v); row_store_f32(outf + (size_t)(m0 + 1) * D, F.lane, w); } }
}
__device__ __forceinline__ void phase_entry_rwkv(const Frame& F, const bf16_t* Hin, bf16_t* Hout, const bf16_t* YE, const int* SLOT, const float* g, const float* mu, bf16_t* X6) {
    const int lane = F.lane;
    for (int ck = F.gw; ck < T / 8; ck += F.NGW) {
        const int m0 = ck * 8, t0 = m0 % SEQ;
        f32x4 prev[4], cur[4], nxt[4];
        if (t0 > 0) { row_fetch<true>(Hin, YE, SLOT, m0 - 1, lane, prev); row_rmsnorm(prev, g, lane); }
        else {
#pragma unroll
            for (int j = 0; j < 4; ++j) prev[j] = (f32x4){0.f, 0.f, 0.f, 0.f}; }
        row_fetch<true>(Hin, YE, SLOT, m0, lane, cur); row_store_bf16(Hout + (size_t)m0 * D, lane, cur); row_rmsnorm(cur, g, lane);
        for (int i = 0; i < 8; ++i) {
            const int m = m0 + i;
            if (t0 + i + 1 < SEQ) { row_fetch<true>(Hin, YE, SLOT, m + 1, lane, nxt); if (i + 1 < 8) row_store_bf16(Hout + (size_t)(m + 1) * D, lane, nxt); row_rmsnorm(nxt, g, lane); }
            else {
#pragma unroll
                for (int j = 0; j < 4; ++j) nxt[j] = (f32x4){0.f, 0.f, 0.f, 0.f}; }
#pragma unroll
            for (int j = 0; j < 4; ++j) { const f32x4 xx = (prev[j] + nxt[j]) * 0.5f - cur[j];
#pragma unroll
                for (int s = 0; s < 6; ++s) { const f32x4 mv = *(const f32x4*)(mu + s * D + 4 * lane + 256 * j); const f32x4 o = cur[j] + xx * mv;
                    u32x2 w; w.x = pk2(o[0], o[1]); w.y = pk2(o[2], o[3]); __builtin_nontemporal_store(w, (u32x2*)(X6 + (size_t)s * T * D + (size_t)m * D + 4 * lane + 256 * j)); } }
#pragma unroll
            for (int j = 0; j < 4; ++j) { prev[j] = cur[j]; cur[j] = nxt[j]; }
        }
    }
}
__device__ __forceinline__ void phase_mix(const Frame& F, const bf16_t* XN, const float* mu, bf16_t* X6) {
    int lane_ = F.lane; asm volatile("" : "+v"(lane_));
    const int gt = F.gw * 64 + lane_, NT = F.NGW * 64;
    for (int idx = gt; idx < T * (D / 8); idx += NT) {
        const int m = idx >> 7, c8 = (idx & 127) * 8, t = m & (SEQ - 1);
        const size_t off = (size_t)m * D + c8; const u32x4 z = (u32x4){0u, 0u, 0u, 0u};
        const u32x4 xp = t > 0 ? *(const u32x4*)(XN + off - D) : z, xc = *(const u32x4*)(XN + off), xq = t < SEQ - 1 ? *(const u32x4*)(XN + off + D) : z;
        float cur[8], xx[8];
#pragma unroll
        for (int q = 0; q < 4; ++q) { cur[2 * q] = bf_lo(xc[q]); cur[2 * q + 1] = bf_hi(xc[q]);
            xx[2 * q] = 0.5f * (bf_lo(xp[q]) + bf_lo(xq[q])) - cur[2 * q]; xx[2 * q + 1] = 0.5f * (bf_hi(xp[q]) + bf_hi(xq[q])) - cur[2 * q + 1]; }
#pragma unroll
        for (int sidx = 0; sidx < 6; ++sidx) { const f32x4 m0 = *(const f32x4*)(mu + sidx * D + c8), m1 = *(const f32x4*)(mu + sidx * D + c8 + 4); u32x4 w;
            w.x = pk2(cur[0] + xx[0] * m0[0], cur[1] + xx[1] * m0[1]); w.y = pk2(cur[2] + xx[2] * m0[2], cur[3] + xx[3] * m0[3]);
            w.z = pk2(cur[4] + xx[4] * m1[0], cur[5] + xx[5] * m1[1]); w.w = pk2(cur[6] + xx[6] * m1[2], cur[7] + xx[7] * m1[3]);
            __builtin_nontemporal_store(w, (u32x4*)(X6 + (size_t)sidx * T * D + off)); }
    }
}
__device__ __forceinline__ void phase_conv_ew(const Frame& F, const bf16_t* U, const bf16_t* BG, const float* cw, bf16_t* G) {
    int lane_ = F.lane; asm volatile("" : "+v"(lane_));
    const int gt = F.gw * 64 + lane_, NT = F.NGW * 64;
    for (int idx = gt; idx < T * (D / 8); idx += NT) {
        const int m = idx >> 7, c8 = (idx & 127) * 8, t = m & (SEQ - 1);
        const size_t off = (size_t)m * D + c8;
        const u32x4 z = (u32x4){0u, 0u, 0u, 0u};
        const u32x4 u0 = t > 0 ? *(const u32x4*)(U + off - D) : z, u1 = *(const u32x4*)(U + off), u2 = t < SEQ - 1 ? *(const u32x4*)(U + off + D) : z, bg = *(const u32x4*)(BG + off);
        float o[8];
#pragma unroll
        for (int q = 0; q < 4; ++q) {
            const float w0a = cw[c8 + 2 * q], w0b = cw[c8 + 2 * q + 1], w1a = cw[D + c8 + 2 * q], w1b = cw[D + c8 + 2 * q + 1], w2a = cw[2 * D + c8 + 2 * q], w2b = cw[2 * D + c8 + 2 * q + 1];
            o[2 * q] = bf_lo(bg[q]) * (bf_lo(u0[q]) * w0a + bf_lo(u1[q]) * w1a + bf_lo(u2[q]) * w2a);
            o[2 * q + 1] = bf_hi(bg[q]) * (bf_hi(u0[q]) * w0b + bf_hi(u1[q]) * w1b + bf_hi(u2[q]) * w2b); }
        u32x4 w; w.x = pk2(o[0], o[1]); w.y = pk2(o[2], o[3]); w.z = pk2(o[4], o[5]); w.w = pk2(o[6], o[7]); __builtin_nontemporal_store(w, (u32x4*)(G + off));
    }
}
__device__ __forceinline__ void phase_router(const Frame& F, const bf16_t* H, const float* g, const float* router, unsigned char* XN8, float* PROBS) {
    LAS u32x4* TB = (LAS u32x4*)F.lds;
    for (int u = F.tid; u < 2048; u += NTHREADS) { const int st = u >> 6, l = u & 63, e = l & 15, k0 = 32 * st + 8 * (l >> 4);
        const f32x4 g0 = *(const f32x4*)(g + k0), g1 = *(const f32x4*)(g + k0 + 4); float x[8];
#pragma unroll
        for (int q = 0; q < 8; ++q) x[q] = router[(size_t)(k0 + q) * NE + e] * (q < 4 ? g0[q & 3] : g1[q & 3]);
        u32x4 hi, lo; hi.x = pk2(x[0], x[1]); hi.y = pk2(x[2], x[3]); hi.z = pk2(x[4], x[5]); hi.w = pk2(x[6], x[7]);
        lo.x = pk2(x[0] - bf_lo(hi.x), x[1] - bf_hi(hi.x)); lo.y = pk2(x[2] - bf_lo(hi.y), x[3] - bf_hi(hi.y)); lo.z = pk2(x[4] - bf_lo(hi.z), x[5] - bf_hi(hi.z)); lo.w = pk2(x[6] - bf_lo(hi.w), x[7] - bf_hi(hi.w));
        TB[(st * 2) * 64 + l] = hi; TB[(st * 2 + 1) * 64 + l] = lo; }
    __syncthreads();
    const int lane = F.lane, fr = lane & 15, fq = lane >> 4, ri = fr & 7;
    for (int tix = F.gw; tix < T / 8; tix += F.NGW) {
        const int row = 8 * tix + ri; const bf16_t* hp = H + (size_t)row * D + 8 * fq;
        int lz = lane; asm volatile("" : "+v"(lz));
        bf16x8 a[32];
#pragma unroll
        for (int st = 0; st < 32; ++st) a[st] = *(const bf16x8*)(hp + 32 * st);
        f32x4 acc = (f32x4){0.f, 0.f, 0.f, 0.f}, gram = (f32x4){0.f, 0.f, 0.f, 0.f};
#pragma unroll
        for (int st = 0; st < 32; ++st) { const u32x4 bh = TB[(st * 2) * 64 + lz], bl = TB[(st * 2 + 1) * 64 + lz];
            acc = __builtin_amdgcn_mfma_f32_16x16x32_bf16(a[st], __builtin_bit_cast(bf16x8, bh), acc, 0, 0, 0);
            acc = __builtin_amdgcn_mfma_f32_16x16x32_bf16(a[st], __builtin_bit_cast(bf16x8, bl), acc, 0, 0, 0);
            gram = __builtin_amdgcn_mfma_f32_16x16x32_bf16(a[st], a[st], gram, 0, 0, 0); }
        const float g0_ = gram[0], g1_ = gram[1], g2_ = gram[2], g3_ = gram[3];
        const float dsel = (fr & 2) ? ((fr & 1) ? g3_ : g2_) : ((fr & 1) ? g1_ : g0_);
        float rs[4];
#pragma unroll
        for (int q = 0; q < 4; ++q) { const float ss = __shfl(q == 0 ? g0_ : (q == 1 ? g1_ : (q == 2 ? g2_ : g3_)), fq * 16 + 4 * fq + q); rs[q] = __builtin_amdgcn_rsqf(ss * (1.f / D) + RMS_EPS); }
        const float rown = __builtin_amdgcn_rsqf(__shfl(dsel, (ri >> 2) * 16 + ri) * (1.f / D) + RMS_EPS);
        float lt[4], mx[4], ex[4], sm[4];
#pragma unroll
        for (int q = 0; q < 4; ++q) { lt[q] = acc[q] * rs[q]; mx[q] = lt[q]; }
#pragma unroll
        for (int o = 1; o < 16; o <<= 1)
#pragma unroll
            for (int q = 0; q < 4; ++q) mx[q] = fmaxf(mx[q], __shfl_xor(mx[q], o));
#pragma unroll
        for (int q = 0; q < 4; ++q) { ex[q] = expf(lt[q] - mx[q]); sm[q] = ex[q]; }
#pragma unroll
        for (int o = 1; o < 16; o <<= 1)
#pragma unroll
            for (int q = 0; q < 4; ++q) sm[q] += __shfl_xor(sm[q], o);
        if (fq < 2) {
#pragma unroll
            for (int q = 0; q < 4; ++q) { const int r = 8 * tix + 4 * fq + q, b = r / SEQ, t = r - b * SEQ; PROBS[((size_t)b * NE + fr) * SEQ + t] = ex[q] / sm[q]; } }
        if (fr < 8) { const float sc = rown * FP8_SX; unsigned char* xp = XN8 + (size_t)row * D + 8 * fq;
#pragma unroll
            for (int st = 0; st < 32; ++st) { const u32x4 w = __builtin_bit_cast(u32x4, a[st]); u32x2 o;
                o.x = pk_fp8x4(bf_lo(w.x) * sc, bf_hi(w.x) * sc, bf_lo(w.y) * sc, bf_hi(w.y) * sc); o.y = pk_fp8x4(bf_lo(w.z) * sc, bf_hi(w.z) * sc, bf_lo(w.w) * sc, bf_hi(w.w) * sc);
                *(u32x2*)(xp + 32 * st) = o; } }
    }
    __syncthreads();
}
__device__ __forceinline__ int wave_incl_scan(int x, int lane) {
#pragma unroll
    for (int o = 1; o < 64; o <<= 1) { const int n = __shfl_up(x, o); if (lane >= o) x += n; }
    return x;
}
__device__ __forceinline__ int wave_sum_i(int v) {
#pragma unroll
    for (int o = 1; o < 64; o <<= 1) v += __shfl_xor(v, o);
    return v;
}
__device__ __forceinline__ int block_exscan(int v, LAS int* tmp, int lane, int wave, int& tot) {
    const int inc = wave_incl_scan(v, lane);
    __syncthreads();
    if (lane == 63) tmp[wave] = inc;
    __syncthreads();
    int off = 0, total = 0;
#pragma unroll
    for (int w = 0; w < NWAVES; ++w) { const int x = tmp[w]; total += x; off += (w < wave) ? x : 0; }
    tot = total; return off + inc - v;
}
__device__ __forceinline__ void select_pair(const Frame& F, int pair, const float* PROBS, int* SLOT, float* AFF, int* GIDX) {
    LAS int* cnt = (LAS int*)F.lds;
    LAS int* tmp = (LAS int*)(F.lds + 64);
    const int tid = F.tid, lane = F.lane, wave = F.wave;
    const int b = pair / NE, e = pair - b * NE, rowbase = (e * NB + b) * CAP;
    const float* p = PROBS + (size_t)pair * SEQ + tid * 8;
    const f32x4 p0 = *(const f32x4*)p, p1 = *(const f32x4*)(p + 4);
    unsigned key[8];
#pragma unroll
    for (int i = 0; i < 4; ++i) { const float fa = p0[i], fb = p1[i]; key[i] = __float_as_uint(fa); key[4 + i] = __float_as_uint(fb); }
    unsigned thr = 0u;
    for (int bit = 30; bit >= 0; --bit) {
        const unsigned cand = thr | (1u << bit); int c = 0;
#pragma unroll
        for (int i = 0; i < 8; ++i) c += (key[i] >= cand) ? 1 : 0;
        c = wave_sum_i(c);
        LAS int* slot = cnt + (bit & 1) * 8;
        if (lane == 0) slot[wave] = c;
        __syncthreads();
        int total = 0;
#pragma unroll
        for (int w = 0; w < NWAVES; ++w) total += slot[w];
        if (total >= CAP) thr = cand;
    }
    int ngt = 0, neq = 0;
#pragma unroll
    for (int i = 0; i < 8; ++i) { ngt += (key[i] > thr) ? 1 : 0; neq += (key[i] == thr) ? 1 : 0; }
    int tot_gt, tot_eq;
    const int gt_before = block_exscan(ngt, tmp, lane, wave, tot_gt); (void)gt_before;
    const int eq_before = block_exscan(neq, tmp, lane, wave, tot_eq);
    const int need = CAP - tot_gt;
    int sel = 0, eqr = eq_before, nsel = 0;
#pragma unroll
    for (int i = 0; i < 8; ++i) { bool s = key[i] > thr; if (key[i] == thr) { s = eqr < need; ++eqr; } if (s) { sel |= 1 << i; ++nsel; } }
    int tot_sel;
    int base = block_exscan(nsel, tmp, lane, wave, tot_sel);
#pragma unroll
    for (int i = 0; i < 8; ++i) { const int t = tid * 8 + i; int sl = -1;
        if (sel & (1 << i)) { sl = base++; GIDX[rowbase + sl] = b * SEQ + t; AFF[(size_t)rowbase + sl] = __uint_as_float(key[i]); }
        SLOT[(size_t)pair * SEQ + t] = sl; }
    __syncthreads();
}
__device__ __forceinline__ float red8(float v) { v += __shfl_xor(v, 1); v += __shfl_xor(v, 2); v += __shfl_xor(v, 4); return v; }
__device__ __forceinline__ float bf1(const bf16_t* p) { return __uint_as_float((unsigned)(*p) << 16); }
#ifdef DBG_WKV
__device__ __forceinline__ void phase_scan_seq(const Frame& F, const bf16_t* R, const bf16_t* Kx, const bf16_t* V, const float* LOGW, const bf16_t* ICLR,
                                               const float* kkw, const float* kaw, const float* rkw, float* Y) {
    const int lane = F.lane;
    for (int item = F.wave * F.G + (int)blockIdx.x; item < 1024; item += NWAVES * F.G) {
        const int chain = item >> 3, rg = item & 7, dir = chain >> 6, bh = chain & 63, b = bh >> 4, h = bh & 15;
        const int rloc = lane >> 3, ks = lane & 7, row = rg * 8 + rloc, c0 = h * 64 + ks * 8;
        float kkc[8], kac[8], S[8];
#pragma unroll
        for (int i = 0; i < 8; ++i) { kkc[i] = kkw[c0 + i]; kac[i] = kaw[c0 + i]; S[i] = 0.f; }
        const float* lwp = LOGW + (size_t)dir * T * D; const bf16_t* icp = ICLR + (size_t)dir * T * D; float* yp = Y + (size_t)dir * T * D;
        const int tfirst = dir ? SEQ - 1 : 0, tstep = dir ? -1 : 1;
        for (int step = 0; step < SEQ; ++step) {
            const int t = tfirst + tstep * step; const size_t m = (size_t)b * SEQ + t; const size_t off = m * D + c0;
            const u32x4 rr = *(const u32x4*)(R + off), kq = *(const u32x4*)(Kx + off), ic = *(const u32x4*)(icp + off);
            const f32x4 l0 = *(const f32x4*)(lwp + off), l1 = *(const f32x4*)(lwp + off + 4);
            const float vv = bf1(V + m * D + h * 64 + row);
            float r[8], k[8], lw[8], a[8];
#pragma unroll
            for (int i = 0; i < 4; ++i) { r[2 * i] = bf_lo(rr[i]); r[2 * i + 1] = bf_hi(rr[i]); k[2 * i] = bf_lo(kq[i]); k[2 * i + 1] = bf_hi(kq[i]); a[2 * i] = bf_lo(ic[i]); a[2 * i + 1] = bf_hi(ic[i]); lw[i] = l0[i]; lw[4 + i] = l1[i]; }
            float kk[8], ss = 0.f;
#pragma unroll
            for (int i = 0; i < 8; ++i) { kk[i] = k[i] * kkc[i]; ss += kk[i] * kk[i]; }
            ss = red8(ss);
            const float inv = fminf(__builtin_amdgcn_rsqf(ss), 1e12f);
            float sa = 0.f, kd[8];
#pragma unroll
            for (int i = 0; i < 8; ++i) { kk[i] *= inv; sa += S[i] * kk[i]; kd[i] = k[i] * (1.f + (a[i] - 1.f) * kac[i]); }
            sa = red8(sa);
            float y = 0.f;
#pragma unroll
            for (int i = 0; i < 8; ++i) { S[i] = S[i] * __expf(lw[i]) - sa * (kk[i] * a[i]) + vv * kd[i]; y += S[i] * r[i]; }
            y = red8(y);
            if (ks == 0) yp[m * D + h * 64 + row] = y;
        }
    }
}
#endif

constexpr int LDT = 72, LDF = 68;
constexpr int TILE_B = 64 * LDT * 2, TILE_F = 64 * LDF * 4;
constexpr int L_KK = 0, L_KKT = TILE_B, L_LKT = 2 * TILE_B, L_R = 3 * TILE_B, L_B = 4 * TILE_B, L_K = 5 * TILE_B, L_BH = 6 * TILE_B, L_KH = 7 * TILE_B, L_VT = 8 * TILE_B;
constexpr int L_LBB = 9 * TILE_B, L_ARB = 10 * TILE_B, L_ARK = 11 * TILE_B;
constexpr int LDP = 40;
constexpr int L_RP = 12 * TILE_B, L_DI = L_RP + 128 * LDP * 2, L_GAMC = L_DI + 64 * LDP * 2, L_LAMP = L_GAMC + 256, L_WKV_END = L_LAMP + 2048;
constexpr int L_RT = L_KKT;
constexpr int L_WT = L_B, L_T2T = L_K, L_XT = L_B, L_E = L_KK, L_FF = L_LBB;
static_assert(L_WKV_END <= RING_BYTES, "wkv LDS map");
typedef const LAS bf16_t* lds_bf;
template <bool SWAP>
__device__ __forceinline__ f32x4 tile_mma(lds_bf X, lds_bf Y, int mt, int nt, int fr, int fq) {
    f32x4 acc = (f32x4){0.f, 0.f, 0.f, 0.f};
#pragma unroll
    for (int kk = 0; kk < 2; ++kk) {
        const bf16x8 xa = *(const LAS bf16x8*)(X + (mt * 16 + fr) * LDT + kk * 32 + fq * 8), yb = *(const LAS bf16x8*)(Y + (nt * 16 + fr) * LDT + kk * 32 + fq * 8);
        acc = SWAP ? __builtin_amdgcn_mfma_f32_16x16x32_bf16(yb, xa, acc, 0, 0, 0) : __builtin_amdgcn_mfma_f32_16x16x32_bf16(xa, yb, acc, 0, 0, 0);
    }
    return acc;
}
__device__ __forceinline__ void wkv_diag_inverse(LAS unsigned char* lds, int lane) {
    const int I = lane >> 4, cc = lane & 15;
    lds_bf LB = (lds_bf)(lds + L_LBB) + (16 * I) * LDT + 16 * I;
    float x[16];
#pragma unroll
    for (int r = 0; r < 16; ++r) {
        float acc = (r == cc) ? 1.f : 0.f;
        if (r > 0) { const u32x4 l0 = *(const LAS u32x4*)(LB + r * LDT), l1 = *(const LAS u32x4*)(LB + r * LDT + 8);
#pragma unroll
            for (int j = 0; j < r; ++j) { const unsigned w = j < 8 ? l0[j >> 1] : l1[(j - 8) >> 1]; const float lv = (j & 1) ? bf_hi(w) : bf_lo(w); acc -= lv * x[j]; } }
        x[r] = acc;
        ((LAS bf16_t*)(lds + L_DI))[(16 * I + r) * LDP + cc] = (bf16_t)f2bf(acc);
    }
}
__device__ __forceinline__ void wkv_solve_blocked(LAS unsigned char* lds, int wave, int fr, int fq) {
    lds_bf XT = (lds_bf)(lds + L_XT) + (16 * wave + fr) * LDT, RT = (lds_bf)(lds + L_RT) + (16 * wave + fr) * LDT, LB = (lds_bf)(lds + L_LBB), DI = (lds_bf)(lds + L_DI);
    LAS bf16_t* RP = (LAS bf16_t*)(lds + L_RP) + (16 * wave + fr) * LDP;
#pragma unroll
    for (int I = 0; I < 4; ++I) {
        f32x4 acc = (f32x4){0.f, 0.f, 0.f, 0.f};
#pragma unroll
        for (int kk = 0; kk < (I == 0 ? 0 : (I == 3 ? 2 : 1)); ++kk) {
            const bf16x8 xa = *(const LAS bf16x8*)(XT + kk * 32 + fq * 8), yb = *(const LAS bf16x8*)(LB + (16 * I + fr) * LDT + kk * 32 + fq * 8);
            acc = __builtin_amdgcn_mfma_f32_16x16x32_bf16(yb, xa, acc, 0, 0, 0); }
        const u32x2 rt = *(const LAS u32x2*)(RT + 16 * I + 4 * fq);
        { u32x2 w; w.x = pk2(bf_lo(rt.x) - acc[0], bf_hi(rt.x) - acc[1]); w.y = pk2(bf_lo(rt.y) - acc[2], bf_hi(rt.y) - acc[3]); *(LAS u32x2*)(RP + 4 * fq) = w; }
        asm volatile("s_waitcnt lgkmcnt(0)" ::: "memory");
        const bf16x8 ra = *(const LAS bf16x8*)(RP + fq * 8), db = *(const LAS bf16x8*)(DI + (16 * I + fr) * LDP + fq * 8);
        const f32x4 xi = __builtin_amdgcn_mfma_f32_16x16x32_bf16(db, ra, (f32x4){0.f, 0.f, 0.f, 0.f}, 0, 0, 0);
        { u32x2 w; w.x = pk2(xi[0], xi[1]); w.y = pk2(xi[2], xi[3]); *(LAS u32x2*)((LAS bf16_t*)XT + 16 * I + 4 * fq) = w; }
        asm volatile("s_waitcnt lgkmcnt(0)" ::: "memory");
    }
}
__device__ __forceinline__ void phase_wkv_prep(const Frame& F, const bf16_t* R, const bf16_t* Kx, const bf16_t* V, const bf16_t* LOGW, const bf16_t* ICLR,
                                               const float* kkw, const float* kaw, const float* rkw, bf16_t* CP, bf16_t* CQ, bf16_t* CG, bf16_t* Y, float* BONUS, const int dbg) {
    LAS unsigned char* lds = F.lds; const int wave = F.wave;
#define OPAQUE_LANE int lane = F.lane; asm volatile("" : "+v"(lane)); const int fr = lane & 15, fq = lane >> 4; (void)fr; (void)fq
    unsigned short in_r[8], in_k[8], in_v[8], in_a[8], in_w[8];
#define WKV_LOAD_INPUTS(item_) do { const int chain_ = (item_) >> 6, ck_ = (item_) & 63, dir_ = chain_ >> 6, bh_ = chain_ & 63, b_ = bh_ >> 4, h_ = bh_ & 15; const int c_ = F.lane; \
        _Pragma("unroll") for (int i = 0; i < 8; ++i) { const int pos_ = ck_ * 64 + wave * 8 + i, t_ = dir_ ? SEQ - 1 - pos_ : pos_; const size_t off_ = ((size_t)b_ * SEQ + t_) * D + h_ * 64 + c_; \
            in_r[i] = R[off_]; in_k[i] = Kx[off_]; in_v[i] = V[off_]; in_a[i] = ICLR[(size_t)dir_ * T * D + off_]; in_w[i] = LOGW[(size_t)dir_ * T * D + off_]; } } while (0)
    for (int u = F.tid; u < (128 * LDP * 2 + 64 * LDP * 2) / 4; u += NTHREADS) ((LAS unsigned*)(lds + L_RP))[u] = 0u;
    if ((int)blockIdx.x < 8192) WKV_LOAD_INPUTS((int)blockIdx.x);
    for (int item = blockIdx.x; item < 8192; item += F.G) {
        const int chain = item >> 6, ck = item & 63, dir = chain >> 6, bh = chain & 63, b = bh >> 4, h = bh & 15;
        if (!(dbg & 1)) {
            OPAQUE_LANE; const int c = lane; const float kkc = kkw[h * 64 + c], kac = kaw[h * 64 + c], rkc = rkw[h * 64 + c];
            float r[8], kk[8], bb[8], kd[8], vv[8], lam[8], kx[8], ax[8], lwx[8]; float run = 0.f; size_t tok[8];
#pragma unroll
            for (int i = 0; i < 8; ++i) {
                const int p = wave * 8 + i, pos = ck * 64 + p, t = dir ? SEQ - 1 - pos : pos; tok[i] = (size_t)b * SEQ + t;
                r[i] = __uint_as_float((unsigned)in_r[i] << 16); kx[i] = __uint_as_float((unsigned)in_k[i] << 16); vv[i] = __uint_as_float((unsigned)in_v[i] << 16); ax[i] = __uint_as_float((unsigned)in_a[i] << 16); lwx[i] = __uint_as_float((unsigned)in_w[i] << 16); }
            float red[16];
#pragma unroll
            for (int i = 0; i < 8; ++i) { const float kr = kx[i] * kkc; kd[i] = kx[i] * (1.f + (ax[i] - 1.f) * kac); red[i] = kr * kr; red[8 + i] = r[i] * kd[i] * rkc; }
            const float tot = reduce_scatter16(red, lane);
#pragma unroll
            for (int i = 0; i < 8; ++i) {
                const float ss = __shfl(tot, ((i >> 2) & 1) * 16 + ((i >> 1) & 1) * 8 + (i & 1) * 4);
                const float inv = fminf(__builtin_amdgcn_rsqf(ss), 1e12f);
                kk[i] = kx[i] * kkc * inv; bb[i] = kk[i] * ax[i];
                run += lwx[i]; lam[i] = run; }
            if ((lane & 35) == 32) { const int i = ((lane >> 4) & 1) * 4 + ((lane >> 3) & 1) * 2 + ((lane >> 2) & 1); BONUS[((size_t)dir * T + tok[0] + (dir ? -i : i)) * RH + h] = tot; }
            LAS float* LAMP = (LAS float*)(lds + L_LAMP);
            LAMP[wave * 64 + c] = run;
            LDS_BARRIER();
            float offs = 0.f, lamC = 0.f;
#pragma unroll
            for (int w = 0; w < NWAVES; ++w) { const float x = LAMP[w * 64 + c]; lamC += x; offs += (w < wave) ? x : 0.f; }
            if (wave == 0) ((LAS float*)(lds + L_GAMC))[c] = __expf(lamC);
            float bh8[8], kh8[8], kt8[8]; const float expC = __expf(lamC); float eprev = __expf(offs);
#pragma unroll
            for (int i = 0; i < 8; ++i) {
                const int p = wave * 8 + i; const float lp = offs + lam[i];
                const float ep = __expf(lp), em = __builtin_amdgcn_rcpf(ep), ec = expC * em;
                kt8[i] = kk[i] * eprev; ((LAS bf16_t*)(lds + L_KK))[p * LDT + c] = (bf16_t)f2bf(kt8[i]);
                ((LAS bf16_t*)(lds + L_R))[p * LDT + c] = (bf16_t)f2bf(r[i] * ep);
                ((LAS bf16_t*)(lds + L_B))[p * LDT + c] = (bf16_t)f2bf(bb[i] * em);
                ((LAS bf16_t*)(lds + L_K))[p * LDT + c] = (bf16_t)f2bf(kd[i] * em);
                bh8[i] = bb[i] * ec; kh8[i] = kd[i] * ec; eprev = ep;
            }
            u32x4 w; w.x = pk2(bh8[0], bh8[1]); w.y = pk2(bh8[2], bh8[3]); w.z = pk2(bh8[4], bh8[5]); w.w = pk2(bh8[6], bh8[7]); *(LAS u32x4*)((LAS bf16_t*)(lds + L_BH) + c * LDT + wave * 8) = w;
            w.x = pk2(kh8[0], kh8[1]); w.y = pk2(kh8[2], kh8[3]); w.z = pk2(kh8[4], kh8[5]); w.w = pk2(kh8[6], kh8[7]); *(LAS u32x4*)((LAS bf16_t*)(lds + L_KH) + c * LDT + wave * 8) = w;
            w.x = pk2(vv[0], vv[1]); w.y = pk2(vv[2], vv[3]); w.z = pk2(vv[4], vv[5]); w.w = pk2(vv[6], vv[7]); *(LAS u32x4*)((LAS bf16_t*)(lds + L_VT) + c * LDT + wave * 8) = w;
            w.x = pk2(kt8[0], kt8[1]); w.y = pk2(kt8[2], kt8[3]); w.z = pk2(kt8[4], kt8[5]); w.w = pk2(kt8[6], kt8[7]); *(LAS u32x4*)((LAS bf16_t*)(lds + L_KKT) + c * LDT + wave * 8) = w;
        }
        LDS_BARRIER();
        if (!(dbg & 2)) {
            OPAQUE_LANE; const int q = wave >> 1; lds_bf X = (lds_bf)(lds + ((q & 2) ? L_R : L_KK)), Yb = (lds_bf)(lds + ((q & 1) ? L_K : L_B));
            f32x4 acc[2][4];
            if (q == 1) {
#pragma unroll
                for (int mi = 0; mi < 2; ++mi)
#pragma unroll
                    for (int nt = 0; nt < 4; ++nt) acc[mi][nt] = tile_mma<false>(X, Yb, 2 * (wave & 1) + mi, nt, fr, fq);
#pragma unroll
                for (int mi = 0; mi < 2; ++mi)
#pragma unroll
                    for (int nt = 0; nt < 4; ++nt) { const int mt = 2 * (wave & 1) + mi;
                        f32x4 a = acc[mi][nt]; const int t0 = mt * 16 + 4 * fq, jc = nt * 16 + fr;
#pragma unroll
                        for (int jj = 0; jj < 4; ++jj) a[jj] = (jc < t0 + jj) ? a[jj] : 0.f;
                        u32x2 w; w.x = pk2(a[0], a[1]); w.y = pk2(a[2], a[3]); *(LAS u32x2*)((LAS bf16_t*)(lds + L_LKT) + jc * LDT + t0) = w; }
            } else {
#pragma unroll
                for (int mi = 0; mi < 2; ++mi)
#pragma unroll
                    for (int nt = 0; nt < 4; ++nt) acc[mi][nt] = tile_mma<true>(X, Yb, 2 * (wave & 1) + mi, nt, fr, fq);
#pragma unroll
                for (int mi = 0; mi < 2; ++mi)
#pragma unroll
                    for (int nt = 0; nt < 4; ++nt) { const int mt = 2 * (wave & 1) + mi; f32x4 a = acc[mi][nt]; const int row = mt * 16 + fr, col = nt * 16 + 4 * fq;
#pragma unroll
                        for (int jj = 0; jj < 4; ++jj) { const bool keep = (q & 2) ? (col + jj <= row) : (col + jj < row); a[jj] = keep ? a[jj] : 0.f; }
                        u32x2 w; w.x = pk2(a[0], a[1]); w.y = pk2(a[2], a[3]);
                        *(LAS u32x2*)((LAS bf16_t*)(lds + (q == 0 ? L_LBB : (q == 2 ? L_ARB : L_ARK))) + row * LDT + col) = w; }
            }
        }
        LDS_BARRIER();
        if (!(dbg & 4)) { OPAQUE_LANE;
            for (int u = F.tid; u < 2 * TILE_B / 4; u += NTHREADS) ((LAS unsigned*)(lds + L_XT))[u] = 0u;
            if (wave == 0) wkv_diag_inverse(lds, lane);
            LDS_BARRIER();
            wkv_solve_blocked(lds, wave, fr, fq); }
        LDS_BARRIER();
        if (item + F.G < 8192) WKV_LOAD_INPUTS(item + F.G);
        if (!(dbg & 8)) {
            OPAQUE_LANE; const int q = wave >> 1; lds_bf X = (lds_bf)(lds + ((q & 2) ? L_ARB : L_BH)), Yb = (lds_bf)(lds + ((q & 1) ? L_T2T : L_WT));
            bf16_t* gout = ((q & 2) ? CQ : CP) + (size_t)item * 4096;
            f32x4 acc[2][4];
#pragma unroll
            for (int mi = 0; mi < 2; ++mi)
#pragma unroll
                for (int nt = 0; nt < 4; ++nt) acc[mi][nt] = tile_mma<true>(X, Yb, 2 * (wave & 1) + mi, nt, fr, fq);
#pragma unroll
            for (int mi = 0; mi < 2; ++mi)
#pragma unroll
                for (int nt = 0; nt < 4; ++nt) { const int mt = 2 * (wave & 1) + mi; const f32x4 a = acc[mi][nt];
                    const int row = mt * 16 + fr, col = nt * 16 + 4 * fq; f32x4 o;
                    if (q == 0) { const float g = ((const LAS float*)(lds + L_GAMC))[row];
#pragma unroll
                        for (int jj = 0; jj < 4; ++jj) o[jj] = ((col + jj == row) ? g : 0.f) - a[jj]; }
                    else if (q == 1) { const u32x2 kh = *(const LAS u32x2*)((lds_bf)(lds + L_KH) + row * LDT + col); o[0] = bf_lo(kh.x) - a[0]; o[1] = bf_hi(kh.x) - a[1]; o[2] = bf_lo(kh.y) - a[2]; o[3] = bf_hi(kh.y) - a[3]; }
                    else if (q == 2) { const u32x2 rr = *(const LAS u32x2*)((lds_bf)(lds + L_R) + row * LDT + col); o[0] = bf_lo(rr.x) - a[0]; o[1] = bf_hi(rr.x) - a[1]; o[2] = bf_lo(rr.y) - a[2]; o[3] = bf_hi(rr.y) - a[3]; }
                    else { const u32x2 ak = *(const LAS u32x2*)((lds_bf)(lds + L_ARK) + row * LDT + col); o[0] = bf_lo(ak.x) - a[0]; o[1] = bf_hi(ak.x) - a[1]; o[2] = bf_lo(ak.y) - a[2]; o[3] = bf_hi(ak.y) - a[3]; }
                    u32x2 w; w.x = pk2(o[0], o[1]); w.y = pk2(o[2], o[3]);
                    if (q == 0 || q == 2) *(u32x2*)(gout + row * 64 + col) = w;
                    else *(LAS u32x2*)((LAS bf16_t*)(lds + (q == 1 ? L_E : L_FF)) + row * LDT + col) = w; }
        }
        LDS_BARRIER();
        if (!(dbg & 16)) {
            OPAQUE_LANE; lds_bf VT = (lds_bf)(lds + L_VT);
            if (wave < 4) {
#pragma unroll
                for (int nt = 0; nt < 4; ++nt) { const f32x4 a = tile_mma<false>((lds_bf)(lds + L_E), VT, wave, nt, fr, fq);
                    u32x2 w; w.x = pk2(a[0], a[1]); w.y = pk2(a[2], a[3]); *(u32x2*)(CG + (size_t)item * 4096 + (nt * 16 + fr) * 64 + wave * 16 + 4 * fq) = w; }
            } else {
                const int mt = wave - 4; const int p = mt * 16 + fr, pos = ck * 64 + p, t = dir ? SEQ - 1 - pos : pos;
                bf16_t* yrow = Y + (size_t)dir * T * D + ((size_t)b * SEQ + t) * D + h * 64;
#pragma unroll
                for (int nt = 0; nt < 4; ++nt) { const f32x4 a = tile_mma<true>((lds_bf)(lds + L_FF), VT, mt, nt, fr, fq); u32x2 w; w.x = pk2(a[0], a[1]); w.y = pk2(a[2], a[3]); *(u32x2*)(yrow + nt * 16 + 4 * fq) = w; }
            }
        }
        LDS_BARRIER();
    }
}

constexpr int P2_SLOT = 8192, P2_HALF = 9 * P2_SLOT + 4096;
constexpr int Q_KK = 0, Q_R = P2_SLOT, Q_B = 2 * P2_SLOT, Q_K = 3 * P2_SLOT, Q_KKT = 4 * P2_SLOT, Q_LKT = 5 * P2_SLOT, Q_LBB = 6 * P2_SLOT, Q_ARB = 7 * P2_SLOT, Q_ARK = 8 * P2_SLOT, Q_MISC = 9 * P2_SLOT;
constexpr int Q_RP = Q_KK, Q_DI = Q_R, Q_XT = Q_B, Q_RT = Q_KKT, Q_BH = Q_KKT, Q_KH = Q_LKT, Q_VT = Q_LBB, Q_E = Q_LKT, Q_F = Q_ARK, Q_GAMC = Q_MISC, Q_LAMP = Q_MISC + 256;
static_assert(2 * P2_HALF <= LDSCTL_OFF, "two prep halves must fit below the LDS control words");
__device__ __forceinline__ int TIX(int r, int c) { return r * 64 + (c ^ ((r & 7) << 3)); }
template <bool SWAP>
__device__ __forceinline__ f32x4 tile_mma2(lds_bf X, lds_bf Y, int mt, int nt, int fr, int fq) {
    f32x4 acc = (f32x4){0.f, 0.f, 0.f, 0.f};
#pragma unroll
    for (int kk = 0; kk < 2; ++kk) {
        const bf16x8 xa = *(const LAS bf16x8*)(X + TIX(mt * 16 + fr, kk * 32 + fq * 8)), yb = *(const LAS bf16x8*)(Y + TIX(nt * 16 + fr, kk * 32 + fq * 8));
        acc = SWAP ? __builtin_amdgcn_mfma_f32_16x16x32_bf16(yb, xa, acc, 0, 0, 0) : __builtin_amdgcn_mfma_f32_16x16x32_bf16(xa, yb, acc, 0, 0, 0);
    }
    return acc;
}
__device__ __forceinline__ void phase_wkv_prep2(const Frame& F, const bf16_t* R, const bf16_t* Kx, const bf16_t* V, const bf16_t* LOGW, const bf16_t* ICLR,
                                                const float* kkw, const float* kaw, const float* rkw, bf16_t* CP, bf16_t* CQ, bf16_t* CG, bf16_t* Y, float* BONUS) {
    const int wave = F.wave, hb = wave >> 2, w4 = wave & 3;
    LAS unsigned char* lds = F.lds + hb * P2_HALF;
    volatile LAS unsigned* hcnt = (volatile LAS unsigned*)(lds + Q_MISC + 2048); unsigned hgen = 0u;
    if (w4 == 0 && F.lane == 0) *hcnt = 0u;
    __syncthreads();
#define HALF_BARRIER() do { asm volatile("s_waitcnt lgkmcnt(0)" ::: "memory"); if (F.lane == 0) __hip_atomic_fetch_add((LAS unsigned*)hcnt, 1u, __ATOMIC_RELAXED, __HIP_MEMORY_SCOPE_WORKGROUP); hgen += 4u; \
        while ((unsigned)__builtin_amdgcn_readfirstlane((int)*hcnt) < hgen) __builtin_amdgcn_s_sleep(1); asm volatile("" ::: "memory"); } while (0)
#define OPQ_LANE int lane = F.lane; asm volatile("" : "+v"(lane)); const int fr = lane & 15, fq = lane >> 4; (void)fr; (void)fq
    for (int pi = blockIdx.x; pi < 4096; pi += F.G) {
        const int item = 2 * pi + hb, chain = item >> 6, ck = item & 63, dir = chain >> 6, bh = chain & 63, b = bh >> 4, h = bh & 15;
        unsigned rrp[8], bhp[8], khp[8], vtp[8];
        {
            OPQ_LANE; const int c = lane; const float kkc = kkw[h * 64 + c], kac = kaw[h * 64 + c], rkc = rkw[h * 64 + c];
            float r[16], kx[16], vv[16], ax[16], lam[16], kd[16]; float run = 0.f;
            const int pos0 = ck * 64 + 16 * w4; const size_t tok0 = (size_t)b * SEQ + (dir ? SEQ - 1 - pos0 : pos0);
            const unsigned base32 = ((unsigned)tok0 * D + h * 64 + c) * 2u;
            const char* pR = (const char*)R; const char* pK = (const char*)Kx; const char* pV = (const char*)V; const char* pA = (const char*)(ICLR + (size_t)dir * T * D); const char* pW = (const char*)(LOGW + (size_t)dir * T * D);
#pragma unroll
            for (int i = 0; i < 16; ++i) { const unsigned o = dir ? base32 - (unsigned)i * (D * 2u) : base32 + (unsigned)i * (D * 2u);
                r[i] = bf1((const bf16_t*)(pR + o)); kx[i] = bf1((const bf16_t*)(pK + o)); vv[i] = bf1((const bf16_t*)(pV + o)); ax[i] = bf1((const bf16_t*)(pA + o)); lam[i] = bf1((const bf16_t*)(pW + o)); }
            float red1[16], red2[16];
#pragma unroll
            for (int i = 0; i < 16; ++i) { const float kr = kx[i] * kkc; kd[i] = kx[i] * (1.f + (ax[i] - 1.f) * kac); red1[i] = kr * kr; red2[i] = r[i] * kd[i] * rkc; }
            const float tot1 = reduce_scatter16(red1, lane), tot2 = reduce_scatter16(red2, lane);
            if ((lane & 3) == 0) { const int i = rs16_index(lane); BONUS[((size_t)dir * T + tok0 + (dir ? -i : i)) * RH + h] = tot2; }
            float kk[16], bb[16];
#pragma unroll
            for (int i = 0; i < 16; ++i) { const float ss = __shfl(tot1, ((i >> 3) & 1) * 32 + ((i >> 2) & 1) * 16 + ((i >> 1) & 1) * 8 + (i & 1) * 4);
                const float inv = fminf(__builtin_amdgcn_rsqf(ss), 1e12f);   kk[i] = kx[i] * kkc * inv; bb[i] = kk[i] * ax[i]; run += lam[i]; lam[i] = run; }
            LAS float* LAMP = (LAS float*)(lds + Q_LAMP);
            LAMP[w4 * 64 + c] = run;
            HALF_BARRIER();
            float offs = 0.f, lamC = 0.f;
#pragma unroll
            for (int w = 0; w < 4; ++w) { const float x = LAMP[w * 64 + c]; lamC += x; offs += (w < w4) ? x : 0.f; }
            const float expC = __expf(lamC); float eprev = __expf(offs);
            if (w4 == 0) ((LAS float*)(lds + Q_GAMC))[c] = expC;
            float kt[16], rr[16], bhv[16], khv[16];
#pragma unroll
            for (int i = 0; i < 16; ++i) { const int p = 16 * w4 + i; const float ep = __expf(offs + lam[i]), em = __builtin_amdgcn_rcpf(ep), ec = expC * em;
                kt[i] = kk[i] * eprev; rr[i] = r[i] * ep; bhv[i] = bb[i] * ec; khv[i] = kd[i] * ec; eprev = ep;
                ((LAS bf16_t*)(lds + Q_KK))[TIX(p, c)] = (bf16_t)f2bf(kt[i]); ((LAS bf16_t*)(lds + Q_R))[TIX(p, c)] = (bf16_t)f2bf(rr[i]);
                ((LAS bf16_t*)(lds + Q_B))[TIX(p, c)] = (bf16_t)f2bf(bb[i] * em); ((LAS bf16_t*)(lds + Q_K))[TIX(p, c)] = (bf16_t)f2bf(kd[i] * em); }
#pragma unroll
            for (int q = 0; q < 8; ++q) { rrp[q] = pk2(rr[2 * q], rr[2 * q + 1]); bhp[q] = pk2(bhv[2 * q], bhv[2 * q + 1]); khp[q] = pk2(khv[2 * q], khv[2 * q + 1]); vtp[q] = pk2(vv[2 * q], vv[2 * q + 1]); }
#pragma unroll
            for (int q = 0; q < 2; ++q) { u32x4 w; w.x = pk2(kt[8 * q], kt[8 * q + 1]); w.y = pk2(kt[8 * q + 2], kt[8 * q + 3]); w.z = pk2(kt[8 * q + 4], kt[8 * q + 5]); w.w = pk2(kt[8 * q + 6], kt[8 * q + 7]);
                *(LAS u32x4*)((LAS bf16_t*)(lds + Q_KKT) + TIX(c, 16 * w4 + 8 * q)) = w; }
        }
        HALF_BARRIER();
        {
            OPQ_LANE; const int q = w4; lds_bf X = (lds_bf)(lds + ((q & 2) ? Q_R : Q_KK)), Yb = (lds_bf)(lds + ((q & 1) ? Q_K : Q_B));
            f32x4 acc[4][4];
            if (q == 1) {
#pragma unroll
                for (int mt = 0; mt < 4; ++mt)
#pragma unroll
                    for (int nt = 0; nt <= mt; ++nt) acc[mt][nt] = tile_mma2<false>(X, Yb, mt, nt, fr, fq);
#pragma unroll
                for (int mt = 0; mt < 4; ++mt)
#pragma unroll
                    for (int nt = 0; nt < 4; ++nt) { const int t0 = mt * 16 + 4 * fq, jc = nt * 16 + fr; u32x2 w = (u32x2){0u, 0u};
                        if (nt <= mt) { f32x4 a = acc[mt][nt];
                            if (nt == mt) {
#pragma unroll
                                for (int jj = 0; jj < 4; ++jj) a[jj] = (jc < t0 + jj) ? a[jj] : 0.f; }
                            w.x = pk2(a[0], a[1]); w.y = pk2(a[2], a[3]); }
                        *(LAS u32x2*)((LAS bf16_t*)(lds + Q_LKT) + TIX(jc, t0)) = w; }
            } else {
#pragma unroll
                for (int mt = 0; mt < 4; ++mt)
#pragma unroll
                    for (int nt = 0; nt <= mt; ++nt) acc[mt][nt] = tile_mma2<true>(X, Yb, mt, nt, fr, fq);
#pragma unroll
                for (int mt = 0; mt < 4; ++mt)
#pragma unroll
                    for (int nt = 0; nt < 4; ++nt) { const int row = mt * 16 + fr, col = nt * 16 + 4 * fq; u32x2 w = (u32x2){0u, 0u};
                        if (nt <= mt) { f32x4 a = acc[mt][nt];
                            if (nt == mt) {
#pragma unroll
                                for (int jj = 0; jj < 4; ++jj) { const bool keep = (q & 2) ? (col + jj <= row) : (col + jj < row); a[jj] = keep ? a[jj] : 0.f; } }
                            w.x = pk2(a[0], a[1]); w.y = pk2(a[2], a[3]); }
                        *(LAS u32x2*)((LAS bf16_t*)(lds + (q == 0 ? Q_LBB : (q == 2 ? Q_ARB : Q_ARK))) + TIX(row, col)) = w; }
            }
        }
        HALF_BARRIER();
        {
            OPQ_LANE;
            if (w4 == 0) {
                const int I = lane >> 4, cc = lane & 15; lds_bf LB = (lds_bf)(lds + Q_LBB); float x[16];
#pragma unroll
                for (int r = 0; r < 16; ++r) {
                    float acc = (r == cc) ? 1.f : 0.f;
                    if (r > 0) { const u32x4 l0 = *(const LAS u32x4*)(LB + TIX(16 * I + r, 16 * I)), l1 = *(const LAS u32x4*)(LB + TIX(16 * I + r, 16 * I + 8));
#pragma unroll
                        for (int j = 0; j < r; ++j) { const unsigned w = j < 8 ? l0[j >> 1] : l1[(j - 8) >> 1]; const float lv = (j & 1) ? bf_hi(w) : bf_lo(w); acc -= lv * x[j]; } }
                    x[r] = acc;
                    ((LAS bf16_t*)(lds + Q_DI))[(16 * I + r) * 32 + cc] = (bf16_t)f2bf(acc);
                }
            } else {
                const int t3 = (w4 - 1) * 64 + lane;
                for (int u = t3; u < 2 * P2_SLOT / 16; u += 192) ((LAS u32x4*)(lds + Q_XT))[u] = (u32x4){0u, 0u, 0u, 0u};
                if (t3 < 128) { const int row = t3 >> 1, hf = t3 & 1; *(LAS u32x4*)((LAS bf16_t*)(lds + Q_DI) + row * 32 + 16 + hf * 8) = (u32x4){0u, 0u, 0u, 0u}; }
            }
        }
        HALF_BARRIER();
        {
            OPQ_LANE; lds_bf LB = (lds_bf)(lds + Q_LBB), DI = (lds_bf)(lds + Q_DI);
#pragma unroll
            for (int I = 0; I < 4; ++I) {
                f32x4 acc[2];
#pragma unroll
                for (int u = 0; u < 2; ++u) { const int col = 16 * (w4 + 4 * u) + fr; acc[u] = (f32x4){0.f, 0.f, 0.f, 0.f};
#pragma unroll
                    for (int kk = 0; kk < (I == 0 ? 0 : (I == 3 ? 2 : 1)); ++kk) {
                        const bf16x8 xa = *(const LAS bf16x8*)((lds_bf)(lds + Q_XT) + TIX(col, kk * 32 + fq * 8)), yb = *(const LAS bf16x8*)(LB + TIX(16 * I + fr, kk * 32 + fq * 8));
                        acc[u] = __builtin_amdgcn_mfma_f32_16x16x32_bf16(yb, xa, acc[u], 0, 0, 0); } }
#pragma unroll
                for (int u = 0; u < 2; ++u) { const int col = 16 * (w4 + 4 * u) + fr; const u32x2 rt = *(const LAS u32x2*)((lds_bf)(lds + Q_RT) + TIX(col, 16 * I + 4 * fq));
                    u32x2 w; w.x = pk2(bf_lo(rt.x) - acc[u][0], bf_hi(rt.x) - acc[u][1]); w.y = pk2(bf_lo(rt.y) - acc[u][2], bf_hi(rt.y) - acc[u][3]);
                    *(LAS u32x2*)((LAS bf16_t*)(lds + Q_RP) + col * 32 + 4 * fq) = w; }
                asm volatile("s_waitcnt lgkmcnt(0)" ::: "memory");
                f32x4 xi[2];
#pragma unroll
                for (int u = 0; u < 2; ++u) { const int col = 16 * (w4 + 4 * u) + fr; const bf16x8 ra = *(const LAS bf16x8*)((lds_bf)(lds + Q_RP) + col * 32 + fq * 8), db = *(const LAS bf16x8*)(DI + (16 * I + fr) * 32 + fq * 8);
                    xi[u] = __builtin_amdgcn_mfma_f32_16x16x32_bf16(db, ra, (f32x4){0.f, 0.f, 0.f, 0.f}, 0, 0, 0); }
#pragma unroll
                for (int u = 0; u < 2; ++u) { const int col = 16 * (w4 + 4 * u) + fr; u32x2 w; w.x = pk2(xi[u][0], xi[u][1]); w.y = pk2(xi[u][2], xi[u][3]); *(LAS u32x2*)((LAS bf16_t*)(lds + Q_XT) + TIX(col, 16 * I + 4 * fq)) = w; }
                asm volatile("s_waitcnt lgkmcnt(0)" ::: "memory");
            }
        }
        HALF_BARRIER();
        {
            OPQ_LANE; const int c = lane;
#pragma unroll
            for (int q = 0; q < 8; ++q) { ((LAS bf16_t*)(lds + Q_R))[TIX(16 * w4 + 2 * q, c)] = (bf16_t)(rrp[q] & 0xffffu); ((LAS bf16_t*)(lds + Q_R))[TIX(16 * w4 + 2 * q + 1, c)] = (bf16_t)(rrp[q] >> 16); }
#pragma unroll
            for (int q = 0; q < 2; ++q) {
                *(LAS u32x4*)((LAS bf16_t*)(lds + Q_BH) + TIX(c, 16 * w4 + 8 * q)) = (u32x4){bhp[4 * q], bhp[4 * q + 1], bhp[4 * q + 2], bhp[4 * q + 3]};
                *(LAS u32x4*)((LAS bf16_t*)(lds + Q_KH) + TIX(c, 16 * w4 + 8 * q)) = (u32x4){khp[4 * q], khp[4 * q + 1], khp[4 * q + 2], khp[4 * q + 3]};
                *(LAS u32x4*)((LAS bf16_t*)(lds + Q_VT) + TIX(c, 16 * w4 + 8 * q)) = (u32x4){vtp[4 * q], vtp[4 * q + 1], vtp[4 * q + 2], vtp[4 * q + 3]}; }
        }
        HALF_BARRIER();
        {
            OPQ_LANE; const int q = w4; lds_bf X = (lds_bf)(lds + ((q & 2) ? Q_ARB : Q_BH)), Yb = (lds_bf)(lds + Q_XT) + ((q & 1) ? 64 * 64 : 0);
            bf16_t* gout = ((q & 2) ? CQ : CP) + (size_t)item * 4096;
            f32x4 acc[4][4];
#pragma unroll
            for (int mt = 0; mt < 4; ++mt)
#pragma unroll
                for (int nt = 0; nt < 4; ++nt) acc[mt][nt] = tile_mma2<true>(X, Yb, mt, nt, fr, fq);
#pragma unroll
            for (int mt = 0; mt < 4; ++mt)
#pragma unroll
                for (int nt = 0; nt < 4; ++nt) { const f32x4 a = acc[mt][nt]; const int row = mt * 16 + fr, col = nt * 16 + 4 * fq; f32x4 o;
                    if (q == 0) { const float g = ((const LAS float*)(lds + Q_GAMC))[row];
#pragma unroll
                        for (int jj = 0; jj < 4; ++jj) o[jj] = ((col + jj == row) ? g : 0.f) - a[jj]; }
                    else { const u32x2 src = *(const LAS u32x2*)((lds_bf)(lds + (q == 1 ? Q_KH : (q == 2 ? Q_R : Q_ARK))) + TIX(row, col));
                        o[0] = bf_lo(src.x) - a[0]; o[1] = bf_hi(src.x) - a[1]; o[2] = bf_lo(src.y) - a[2]; o[3] = bf_hi(src.y) - a[3]; }
                    u32x2 w; w.x = pk2(o[0], o[1]); w.y = pk2(o[2], o[3]);
                    if (q == 0 || q == 2) *(u32x2*)(gout + row * 64 + col) = w;
                    else *(LAS u32x2*)((LAS bf16_t*)(lds + (q == 1 ? Q_E : Q_F)) + TIX(row, col)) = w; }
        }
        HALF_BARRIER();
        {
            OPQ_LANE; lds_bf VT = (lds_bf)(lds + Q_VT);
            if (w4 < 2) {
#pragma unroll
                for (int mi = 0; mi < 2; ++mi)
#pragma unroll
                    for (int nt = 0; nt < 4; ++nt) { const int mt = 2 * w4 + mi; const f32x4 a = tile_mma2<false>((lds_bf)(lds + Q_E), VT, mt, nt, fr, fq);
                        u32x2 w; w.x = pk2(a[0], a[1]); w.y = pk2(a[2], a[3]); *(u32x2*)(CG + (size_t)item * 4096 + (nt * 16 + fr) * 64 + mt * 16 + 4 * fq) = w; }
            } else {
#pragma unroll
                for (int mi = 0; mi < 2; ++mi) { const int mt = 2 * (w4 - 2) + mi; const int p = mt * 16 + fr;
                    bf16_t* yrow = Y + (((size_t)chain * 64 + ck) * 64 + p) * 64;
#pragma unroll
                    for (int nt = 0; nt < 4; ++nt) { const f32x4 a = tile_mma2<true>((lds_bf)(lds + Q_F), VT, mt, nt, fr, fq); u32x2 w; w.x = pk2(a[0], a[1]); w.y = pk2(a[2], a[3]); *(u32x2*)(yrow + nt * 16 + 4 * fq) = w; } }
            }
        }
        HALF_BARRIER();
    }
#undef OPQ_LANE
#undef HALF_BARRIER
    __syncthreads();
}
__device__ __forceinline__ void phase_wkv_scan(const Frame& F, const bf16_t* CP, const bf16_t* CQ, const bf16_t* CG, bf16_t* Y) {
    LAS unsigned char* lds = F.lds; const int lane = F.lane, wave = F.wave, fr = lane & 15, fq = lane >> 4;
    LAS bf16_t* SL = (LAS bf16_t*)lds;
    constexpr int SLOT0 = 16384, SLOTB = 24576, OQ = 8192, OG = 16384, OY = 20480;
    for (int item = blockIdx.x; item < 256; item += F.G) {
        const int vh = (item >> 3) & 1, chain = ((item >> 4) << 3) + (item & 7);
        const int vt = wave >> 2, ct = wave & 3;
        const int tt = wave >> 1, vt2 = wave & 1;
        const int dr = wave * 8 + (lane >> 3), dj = (lane & 7) ^ (dr & 7);
        const unsigned offPQ = (unsigned)(dr * 128 + dj * 16);
        const int gr = (wave & 3) * 8 + (lane >> 3);
        const unsigned off3 = wave < 4 ? (unsigned)((vh * 32 + gr) * 128 + (((lane & 7) ^ (gr & 7)) * 16)) : (unsigned)((((wave & 3) * 16 + (lane >> 2)) * 128) + vh * 64 + (lane & 3) * 16);
        const bf16_t* src3 = wave < 4 ? CG : (const bf16_t*)Y;
        const unsigned lds3 = wave < 4 ? (unsigned)(OG + wave * 1024) : (unsigned)(OY + (wave & 3) * 1024);
#define WKV_STAGE(ck_) do { const size_t it_ = ((size_t)chain * 64 + (ck_)) * 8192; const unsigned sb_ = SLOT0 + ((ck_) & 3) * SLOTB; \
            __builtin_amdgcn_global_load_lds((const unsigned*)((const char*)CP + it_ + offPQ), (LAS unsigned*)(lds + sb_ + wave * 1024), 16, 0, 0); \
            __builtin_amdgcn_global_load_lds((const unsigned*)((const char*)CQ + it_ + offPQ), (LAS unsigned*)(lds + sb_ + OQ + wave * 1024), 16, 0, 0); \
            __builtin_amdgcn_global_load_lds((const unsigned*)((const char*)src3 + it_ + off3), (LAS unsigned*)(lds + sb_ + lds3), 16, 0, 2); } while (0)
#define WKV_VMW(n) asm volatile("s_waitcnt vmcnt(" #n ")" ::: "memory")
        for (int u = F.tid; u < 32 * LDT / 2; u += NTHREADS) ((LAS unsigned*)SL)[u] = 0u;
        WKV_STAGE(0); WKV_STAGE(1); WKV_STAGE(2);
        WKV_VMW(6); LDS_BARRIER();
        const int sw = fr & 7;
        const unsigned aP0 = (unsigned)((ct * 16 + fr) * 128 + ((fq ^ sw) * 16)), aP1 = (unsigned)((ct * 16 + fr) * 128 + (((4 + fq) ^ sw) * 16));
        const unsigned aQ0 = (unsigned)(OQ + (tt * 16 + fr) * 128 + ((fq ^ sw) * 16)), aQ1 = (unsigned)(OQ + (tt * 16 + fr) * 128 + (((4 + fq) ^ sw) * 16));
        const unsigned aG = (unsigned)(OG + (vt * 16 + fr) * 128 + (((ct * 2 + (fq >> 1)) ^ sw) * 16) + (fq & 1) * 8);
        const unsigned aY = (unsigned)(OY + (tt * 16 + fr) * 64 + vt2 * 32 + fq * 8);
        bf16_t* ybase = Y + ((size_t)chain * 64 * 64 + tt * 16 + fr) * 64 + vh * 32 + vt2 * 16 + 4 * fq;
        for (int ck0 = 0; ck0 < 64; ck0 += 4) {
#pragma unroll
            for (int u = 0; u < 4; ++u) {
                const int ck = ck0 + u;
                if (ck + 3 < 64) WKV_STAGE(ck + 3);
                LAS unsigned char* sb = lds + SLOT0 + u * SLOTB;
                const u32x2 gg = *(const LAS u32x2*)(sb + aG), yy = *(const LAS u32x2*)(sb + aY);
                const bf16x8 p0 = *(const LAS bf16x8*)(sb + aP0), p1 = *(const LAS bf16x8*)(sb + aP1), q0 = *(const LAS bf16x8*)(sb + aQ0), q1 = *(const LAS bf16x8*)(sb + aQ1);
                f32x4 sacc = (f32x4){bf_lo(gg.x), bf_hi(gg.x), bf_lo(gg.y), bf_hi(gg.y)}, yacc = (f32x4){bf_lo(yy.x), bf_hi(yy.x), bf_lo(yy.y), bf_hi(yy.y)};
                const LAS bf16_t* S0 = SL + (u & 1) * (32 * LDT); LAS bf16_t* S1 = SL + ((u & 1) ^ 1) * (32 * LDT);
                const bf16x8 sx0 = *(const LAS bf16x8*)(S0 + (vt * 16 + fr) * LDT + fq * 8), sy0 = *(const LAS bf16x8*)(S0 + (vt2 * 16 + fr) * LDT + fq * 8);
                const bf16x8 sx1 = *(const LAS bf16x8*)(S0 + (vt * 16 + fr) * LDT + 32 + fq * 8), sy1 = *(const LAS bf16x8*)(S0 + (vt2 * 16 + fr) * LDT + 32 + fq * 8);
                sacc = __builtin_amdgcn_mfma_f32_16x16x32_bf16(p0, sx0, sacc, 0, 0, 0);
                yacc = __builtin_amdgcn_mfma_f32_16x16x32_bf16(sy0, q0, yacc, 0, 0, 0);
                sacc = __builtin_amdgcn_mfma_f32_16x16x32_bf16(p1, sx1, sacc, 0, 0, 0);
                yacc = __builtin_amdgcn_mfma_f32_16x16x32_bf16(sy1, q1, yacc, 0, 0, 0);
                { u32x2 w; w.x = pk2(yacc[0], yacc[1]); w.y = pk2(yacc[2], yacc[3]); *(u32x2*)(ybase + (size_t)ck * 4096) = w; }
                { u32x2 w; w.x = pk2(sacc[0], sacc[1]); w.y = pk2(sacc[2], sacc[3]); *(LAS u32x2*)(S1 + (vt * 16 + fr) * LDT + ct * 16 + 4 * fq) = w; }
                if (u == 0) { if (ck0 == 0) WKV_VMW(7); else WKV_VMW(9); }
                else if (u == 1) { if (ck0 == 0) WKV_VMW(8); else if (ck0 == 60) WKV_VMW(0); else WKV_VMW(9); }
                else { if (ck0 == 60) WKV_VMW(0); else WKV_VMW(9); }
                LDS_BARRIER();
            }
        }
#undef WKV_STAGE
#undef WKV_VMW
    }
}

__device__ __forceinline__ void phase_gn(const Frame& F, const bf16_t* Y, const float* BONUS, const bf16_t* V, const bf16_t* GATE, const float* lnw, const float* lnb, bf16_t* Z) {
    const int lane = F.lane, h = lane >> 2;
    for (int m = F.gw; m < T; m += F.NGW) {
        const size_t off = (size_t)m * D + 16 * lane;
        float y[16]; float s = 0.f;
        const int bb_ = m / SEQ, t_ = m - bb_ * SEQ, pr_ = SEQ - 1 - t_;
        const bf16_t* yf = Y + ((((size_t)(bb_ * 16 + h)) * 64 + (t_ >> 6)) * 64 + (t_ & 63)) * 64 + 16 * (lane & 3);
        const bf16_t* yb = Y + ((((size_t)(64 + bb_ * 16 + h)) * 64 + (pr_ >> 6)) * 64 + (pr_ & 63)) * 64 + 16 * (lane & 3);
#pragma unroll
        for (int q = 0; q < 2; ++q) { const u32x4 a = *(const u32x4*)(yf + 8 * q), b = *(const u32x4*)(yb + 8 * q);
#pragma unroll
            for (int j = 0; j < 4; ++j) { y[8 * q + 2 * j] = bf_lo(a[j]) + bf_lo(b[j]); y[8 * q + 2 * j + 1] = bf_hi(a[j]) + bf_hi(b[j]); s += y[8 * q + 2 * j] + y[8 * q + 2 * j + 1]; } }
        s += __shfl_xor(s, 1); s += __shfl_xor(s, 2);
        const float mean = s * (1.f / 64.f); float qq = 0.f;
#pragma unroll
        for (int j = 0; j < 16; ++j) { y[j] -= mean; qq += y[j] * y[j]; }
        qq += __shfl_xor(qq, 1); qq += __shfl_xor(qq, 2);
        const float rs = __builtin_amdgcn_rsqf(qq * (1.f / 64.f) + GN_EPS);
        const float bon = BONUS[(size_t)m * RH + h] + BONUS[(size_t)T * RH + (size_t)m * RH + h];
        const u32x4 g0 = *(const u32x4*)(GATE + off), g1 = *(const u32x4*)(GATE + off + 8);
        float o[16];
#pragma unroll
        for (int q = 0; q < 4; ++q) { const f32x4 w = *(const f32x4*)(lnw + 16 * lane + 4 * q), bb = *(const f32x4*)(lnb + 16 * lane + 4 * q); const u32x2 vb = *(const u32x2*)(V + off + 4 * q);
            const f32x4 vv = (f32x4){bf_lo(vb.x), bf_hi(vb.x), bf_lo(vb.y), bf_hi(vb.y)};
#pragma unroll
            for (int j = 0; j < 4; ++j) o[4 * q + j] = y[4 * q + j] * rs * w[j] + bb[j] + bon * vv[j]; }
#pragma unroll
        for (int q = 0; q < 4; ++q) { o[2 * q] *= bf_lo(g0[q]); o[2 * q + 1] *= bf_hi(g0[q]); o[8 + 2 * q] *= bf_lo(g1[q]); o[8 + 2 * q + 1] *= bf_hi(g1[q]); }
        u32x4 w0, w1; w0.x = pk2(o[0], o[1]); w0.y = pk2(o[2], o[3]); w0.z = pk2(o[4], o[5]); w0.w = pk2(o[6], o[7]); w1.x = pk2(o[8], o[9]); w1.y = pk2(o[10], o[11]); w1.z = pk2(o[12], o[13]); w1.w = pk2(o[14], o[15]);
        __builtin_nontemporal_store(w0, (u32x4*)(Z + off)); __builtin_nontemporal_store(w1, (u32x4*)(Z + off + 8));
    }
}

constexpr int PH_PER_LAYER = 16, PH_FINAL = 1 + NL * PH_PER_LAYER, PH_COUNT = PH_FINAL + 1;
constexpr size_t TILE1024 = (size_t)256 * 1024 * 2;
typedef pg8::GroupSched<64, 4, 1, 0, 0, 0, 0, 0, TILE1024, TILE1024> SchedN4;
typedef pg8::GroupSched<64, 12, 1, 0, 0, 0, 0, 0, TILE1024, TILE1024> SchedN12;
typedef pg8::GroupSched<64, 4, 3, 0, 0, (size_t)T * D * 2, SZ_SQ, 0, TILE1024, TILE1024> SchedRKV;
typedef pg8::GroupSched<64, 1, 3, 0, 0, (size_t)T * D * 2, TILE1024, 0, TILE1024, TILE1024> SchedL1;
typedef pg8::GroupSched<64, 4, 5, 0, 3, (size_t)T * 128 * 2, (size_t)1024 * 128 * 2, 0, (size_t)256 * 128 * 2, (size_t)256 * 128 * 2> SchedL2;
typedef pg8::GroupSched<4, 4, 4, 0, 0, SZ_SQ, 2 * SZ_SQ, 0, TILE1024, TILE1024> SchedKM;
typedef pg8::GroupSched<4, 4, 4, 0, 0, 2 * SZ_SQ, SZ_SQ, 0, TILE1024, TILE1024> SchedVT;
typedef pg8::GroupSched<128, 8, 1, 8, 0, 0, 0, (size_t)2048 * 1024, 0, TILE1024 / 2> SchedUp;
typedef pg8::GroupSched<128, 4, 1, 8, 0, 0, 0, SZ_SQ / 2, TILE1024 / 2, TILE1024 / 2> SchedDown;
typedef pg8::OneUnitSched<TILE1024, TILE1024> SchedOne;
template <bool VO>
struct FoldSched {
    const char* A0; const char* B0; int G, c;
    __device__ __forceinline__ bool next(int i, pg8::Unit& u) const {
        const int L = i * G + c; if (L >= 256) return false;
        const int l = L >> 6, b = (L >> 4) & 3, h = (L >> 2) & 3, t = L & 3;
        if (VO) { u.a = A0 + (size_t)l * SZ_SQ + (size_t)t * TILE1024 + h * 512; u.b = B0 + (size_t)l * SZ_SQ + (size_t)b * TILE1024 + h * 512; u.pm = t; u.pn = h; u.sub = l * 4 + b; }
        else { u.a = A0 + (size_t)l * SZ_SQ + (size_t)b * TILE1024 + h * 512; u.b = B0 + (size_t)l * SZ_SQ + (size_t)t * TILE1024 + h * 512; u.pm = 0; u.pn = t; u.sub = (l * 4 + b) * 4 + h; }
        return true;
    }
};
typedef pg8::GroupSched<64, 4, 1, 16, 0, 0, 0, SZ_SQ, TILE1024, TILE1024> SchedPVO;
typedef pg8::AttnSched<TILE1024, 512> SchedQK;
typedef pg8::AttnSched<512, TILE1024> SchedPV;

#ifndef PHMASK
#define PHMASK 0xFFFFFFFFu
#endif
#define PH_EN(k) (((PHMASK) >> (k)) & 1u)
#define PH_IN(id) (PH_EN(PHG) && lo <= (id) && (id) < hi)
#ifndef REPMASK
#define REPMASK 0u
#endif
#ifndef REPN
#define REPN 1
#endif
#define PH_IF(cond) if (cond) for (int rep_ = 0; rep_ < ((((REPMASK) >> PHG) & 1u) ? (REPN) : 1); ++rep_)
#define PH_SYNC(id) do { if ((id) + 1 < hi) xcd_barrier(bar); } while (0)
#define WSL unsigned char* const wsl = (unsigned char*)inp(args, I_WS)
#define WSP(T_, off) ((T_*)(wsl + (off)))
#define POOLP(T_, off) ((T_*)(wsl + WS_POOL + (off)))
#define HCUR WSP(bf16_t, (i & 1) ? WS_HB : WS_HA)
#define HPREV WSP(const bf16_t, (i & 1) ? WS_HA : WS_HB)
#define BX ((int)blockIdx.x)
template <int i>
__device__ __forceinline__ void run_layer(const Frame& F, const Args& args, const XcdBarrier& bar, const int lo, const int hi) {
    using namespace pg8;
    constexpr int base = 1 + i * PH_PER_LAYER, j = i >> 1;
    if constexpr ((i & 1) != 0) {
#define PHG 1
        PH_IF(PH_IN(base + 0)) { WSL;
            phase_entry_plain<0>(F, HPREV, HCUR, POOLP(const bf16_t, PO_YE), WSP(const int, WS_SLOT), inp(args, I_NMIX) + i * D, WSP(bf16_t, WS_XN), nullptr);
            PH_SYNC(base + 0); }
#undef PHG
#define PHG 22
        PH_IF(PH_IN(base + 1)) { WSL; phase_mix(F, WSP(const bf16_t, WS_XN), inp(args, I_MU) + (size_t)j * 6 * D, POOLP(bf16_t, PO_X6)); PH_SYNC(base + 1); }
#undef PHG
#define PHG 2
        PH_IF(PH_IN(base + 2)) { WSL;
            { SchedRKV S{(const char*)POOLP(bf16_t, PO_X6), (const char*)(wsl + WS_RKV + (size_t)j * 3 * SZ_SQ), F.G, BX};
              EpiBf16 E{POOLP(bf16_t, PO_RKV), 1024, (size_t)T * D, 1.f}; gemm_phase<1024, 1024, 1024, EpiBf16, SchedRKV, true>(F.lds, S, E); }
            { SchedL1 S{(const char*)(POOLP(bf16_t, PO_X6) + (size_t)3 * T * D), (const char*)(wsl + WS_L1 + (size_t)j * SZ_L1), F.G, BX};
              EpiLora1 E{POOLP(bf16_t, PO_LORA)}; gemm_phase<1024, 1024, 1024, EpiLora1, SchedL1, true, true, false, false, true>(F.lds, S, E); }
            PH_SYNC(base + 2); }
#undef PHG
#define PHG 3
        PH_IF(PH_IN(base + 3)) { WSL;
            SchedL2 S{(const char*)POOLP(bf16_t, PO_LORA), (const char*)(wsl + WS_L2 + (size_t)j * SZ_L2), F.G, BX};
            EpiLora2 E{POOLP(bf16_t, PO_LOGW), POOLP(bf16_t, PO_ICLR), POOLP(bf16_t, PO_GATE), inp(args, I_W0) + (size_t)j * 2 * D, inp(args, I_A0) + (size_t)j * 2 * D};
            gemm_phase<128, 128, 128, EpiLora2, SchedL2, true>(F.lds, S, E);
            PH_SYNC(base + 3); }
#undef PHG
#define PHG 4
        PH_IF(PH_IN(base + 4)) { WSL;
            const bf16_t* RKV = POOLP(const bf16_t, PO_RKV);
            phase_wkv_prep2(F, RKV, RKV + (size_t)T * D, RKV + (size_t)2 * T * D, POOLP(const bf16_t, PO_LOGW), POOLP(const bf16_t, PO_ICLR), inp(args, I_KK) + j * D, inp(args, I_KA) + j * D, inp(args, I_RK) + j * D,
                            POOLP(bf16_t, PO_CP), POOLP(bf16_t, PO_CQ), POOLP(bf16_t, PO_CG), POOLP(bf16_t, PO_Y), POOLP(float, PO_BONUS));
            PH_SYNC(base + 4); }
#undef PHG
#define PHG 21
        PH_IF(PH_IN(base + 5)) { WSL;
            phase_wkv_scan(F, POOLP(const bf16_t, PO_CP), POOLP(const bf16_t, PO_CQ), POOLP(const bf16_t, PO_CG), POOLP(bf16_t, PO_Y));
#ifdef DBG_WKV
            { const bf16_t* RKV = POOLP(const bf16_t, PO_RKV);
              phase_scan_seq(F, RKV, RKV + (size_t)T * D, RKV + (size_t)2 * T * D, POOLP(const float, PO_LOGW), POOLP(const bf16_t, PO_ICLR), inp(args, I_KK) + j * D, inp(args, I_KA) + j * D, inp(args, I_RK) + j * D, WSP(float, WS_WGU)); }
#endif
            PH_SYNC(base + 5); }
#undef PHG
#define PHG 5
        PH_IF(PH_IN(base + 6)) { WSL;
            phase_gn(F, POOLP(const bf16_t, PO_Y), POOLP(const float, PO_BONUS), POOLP(const bf16_t, PO_RKV) + (size_t)2 * T * D, POOLP(const bf16_t, PO_GATE), inp(args, I_LNW) + j * D, inp(args, I_LNB) + j * D, POOLP(bf16_t, PO_Z));
            PH_SYNC(base + 6); }
#undef PHG
#define PHG 6
        PH_IF(PH_IN(base + 7)) { WSL;
            SchedN4 S{(const char*)POOLP(bf16_t, PO_Z), (const char*)(wsl + WS_ROUT + (size_t)j * SZ_SQ), F.G, BX};
            EpiResidualT<false, true> E{HCUR, HCUR, WSP(float, WS_XN)}; gemm_phase<1024, 1024, 1024, EpiResidualT<false, true>, SchedN4, true>(F.lds, S, E);
            PH_SYNC(base + 7); }
#undef PHG
    } else {
#define PHG 7
        PH_IF(i > 0 && PH_IN(base + 0)) { WSL;
            phase_entry_plain<0>(F, HPREV, HCUR, POOLP(const bf16_t, PO_YE), WSP(const int, WS_SLOT), inp(args, I_NMIX) + i * D, WSP(bf16_t, WS_XN), nullptr);
            PH_SYNC(base + 0); }
#undef PHG
#define PHG 8
        PH_IF(PH_IN(base + 1)) { WSL;
            { SchedN12 S{(const char*)WSP(bf16_t, WS_XN), (const char*)(wsl + WS_CONVIN + (size_t)j * SZ_CONVIN), F.G, BX};
              EpiConvIn E{POOLP(bf16_t, PO_U), POOLP(bf16_t, PO_BG)}; gemm_phase<1024, 1024, 1024, EpiConvIn, SchedN12, true>(F.lds, S, E); }
            if (i == 0) {
                { SchedKM S{(const char*)(wsl + WS_MEMN), (const char*)(wsl + WS_WKV), F.G, BX};
                  EpiBf16 E{WSP(bf16_t, WS_KM), 1024, (size_t)1024 * 1024, 1.f}; gemm_phase<1024, 1024, 1024, EpiBf16, SchedKM, true>(F.lds, S, E); }
                { SchedKM S{(const char*)(wsl + WS_MEMN), (const char*)(wsl + WS_WKV + SZ_SQ), F.G, BX};
                  EpiBf16 E{WSP(bf16_t, WS_VT), 1024, (size_t)1024 * 1024, 1.f}; gemm_phase<1024, 1024, 1024, EpiBf16, SchedKM, true>(F.lds, S, E); }
            }
            PH_SYNC(base + 1); }
#undef PHG
#define PHG 9
        PH_IF(PH_IN(base + 2)) { WSL; phase_conv_ew(F, POOLP(const bf16_t, PO_U), POOLP(const bf16_t, PO_BG), inp(args, I_CONV_W) + (size_t)j * 3 * D, POOLP(bf16_t, PO_G));
            if (i == 0) {
                __syncthreads();
                { FoldSched<false> S{(const char*)(wsl + WS_KM), (const char*)(wsl + WS_WQ), F.G, BX};
                  EpiBf16 E{POOLP(bf16_t, PO_WQK), 1024, (size_t)256 * 1024, 1.f}; gemm_phase<1024, 1024, 256, EpiBf16, FoldSched<false>, true>(F.lds, S, E); }
                { FoldSched<true> S{(const char*)(wsl + WS_WO), (const char*)(wsl + WS_VT), F.G, BX};
                  EpiBf16 E{POOLP(bf16_t, PO_VOT), 1024, (size_t)1024 * 1024, 1.f}; gemm_phase<1024, 1024, 256, EpiBf16, FoldSched<true>, true>(F.lds, S, E); }
            }
            PH_SYNC(base + 2); }
#undef PHG
#define PHG 10
        PH_IF(PH_IN(base + 3)) { WSL;
            SchedN4 S{(const char*)POOLP(bf16_t, PO_G), (const char*)(wsl + WS_CONVOUT + (size_t)j * SZ_SQ), F.G, BX};
            if (i == 0) { EpiResidualT<true, true> E{inp(args, I_X), HCUR, WSP(float, WS_XN)}; gemm_phase<1024, 1024, 1024, EpiResidualT<true, true>, SchedN4, true>(F.lds, S, E); }
            else { EpiResidualT<false, true> E{HCUR, HCUR, WSP(float, WS_XN)}; gemm_phase<1024, 1024, 1024, EpiResidualT<false, true>, SchedN4, true>(F.lds, S, E); }
            PH_SYNC(base + 3); }
#undef PHG
    }
#define PHG 11
#undef PHG
#define PHG 12
    PH_IF(PH_IN(base + 9)) { WSL;
        const SchedN4 SM{nullptr, nullptr, F.G, BX};
        for (int it = 0; ; ++it) { Unit um; if (!SM.next(it, um)) break; const int pm = um.pm, h = um.pn, b = pm >> 4;
            LAS float* RS = (LAS float*)(F.lds + RING_BYTES);
            if (F.tid < 256) { const f32x4* pp = (const f32x4*)(WSP(const float, WS_XN) + (size_t)(pm * 256 + F.tid) * 16); const f32x4 a = pp[0], b = pp[1], c = pp[2], d = pp[3];
                const f32x4 t4 = (a + b) + (c + d); RS[F.tid] = __builtin_amdgcn_rsqf(((t4[0] + t4[1]) + (t4[2] + t4[3])) * (1.f / D) + RMS_EPS); }
            __syncthreads();
            { SchedOne S{(const char*)HCUR, (const char*)POOLP(bf16_t, PO_WQK) + (size_t)((i * 4 + b) * 4) * TILE1024, pm, h};
              EpiSoftmax E{POOLP(bf16_t, PO_P), RS, 1.4426950408889634f / 16.f}; gemm_phase<1024, 1024, 1024, EpiSoftmax, SchedOne, false>(F.lds, S, E); }
            VM_WAIT(); __syncthreads();
        }
        PH_SYNC(base + 9); }
#undef PHG
#define PHG 15
    PH_IF(PH_IN(base + 10)) { WSL;
        SchedPVO S{(const char*)POOLP(bf16_t, PO_P), (const char*)POOLP(bf16_t, PO_VOT) + (size_t)i * 4 * SZ_SQ, F.G, BX};
        EpiResidual E{HCUR, HCUR}; gemm_phase<1024, 1024, 1024, EpiResidual, SchedPVO, true>(F.lds, S, E);
        PH_SYNC(base + 10); }
#undef PHG
#define PHG 16
    PH_IF(PH_IN(base + 11)) { WSL; phase_router(F, HCUR, inp(args, I_NFFN) + i * D, inp(args, I_ROUTER) + (size_t)i * D * NE, POOLP(unsigned char, PO_XE), WSP(float, WS_PROBS)); PH_SYNC(base + 11); }
#undef PHG
#define PHG 17
    PH_IF(PH_IN(base + 12)) { WSL;
        if (F.G > 64) {
            if (BX < 64) { if (!(args.dbg & 64)) select_pair(F, BX, WSP(const float, WS_PROBS), WSP(int, WS_SLOT), WSP(float, WS_AFF), WSP(int, WS_GIDX)); }
            else if (!(args.dbg & 32)) moe_convert(F, args, i, (BX - 64) * NWAVES + F.wave, (F.G - 64) * NWAVES);
        } else {
            for (int pr = BX; pr < 64; pr += F.G) select_pair(F, pr, WSP(const float, WS_PROBS), WSP(int, WS_SLOT), WSP(float, WS_AFF), WSP(int, WS_GIDX));
            moe_convert(F, args, i, BX * NWAVES + F.wave, F.G * NWAVES);
        }
        PH_SYNC(base + 12); }
#undef PHG
#define PHG 18
    PH_IF(PH_IN(base + 13)) { WSL;
        SchedUp S{(const char*)POOLP(unsigned char, PO_XE), (const char*)(wsl + WS_WGU), F.G, BX};
        EpiSwiGLU8 E{POOLP(unsigned char, PO_HID)}; gemm_phase<512, 512, 512, EpiSwiGLU8, SchedUp, true, true, true, true>(F.lds, S, E, WSP(const int, WS_GIDX));
        PH_SYNC(base + 13); }
#undef PHG
#define PHG 19
    PH_IF(PH_IN(base + 14)) { WSL;
        SchedDown S{(const char*)POOLP(bf16_t, PO_HID), (const char*)(wsl + WS_WD), F.G, BX};
        EpiDown E{POOLP(bf16_t, PO_YE), WSP(const float, WS_AFF), 1.f / (FP8_SH * FP8_SW)}; gemm_phase<512, 512, 512, EpiDown, SchedDown, true, true, false, true>(F.lds, S, E);
        PH_SYNC(base + 14); }
#undef PHG
}

__global__ void __launch_bounds__(NTHREADS, 2) fwd_kernel(Args args) {
    extern __shared__ __attribute__((aligned(16))) unsigned char lds_raw[];
    Frame F;
    F.lds = (LAS unsigned char*)lds_raw;
    F.tid = threadIdx.x; F.lane = F.tid & 63; F.wave = __builtin_amdgcn_readfirstlane(F.tid >> 6);
    F.G = gridDim.x; { const int bx = blockIdx.x; const int vcu = (F.G % 8 == 0) ? (bx % 8) * (F.G / 8) + bx / 8 : bx; F.gw = vcu * NWAVES + F.wave; F.NGW = F.G * NWAVES; }
    F.ws = args.ws;
    for (int u = F.tid; u < (LDS_BYTES - LDSCTL_OFF) / 4; u += NTHREADS) ((LAS unsigned*)(F.lds + LDSCTL_OFF))[u] = 0u;
    __syncthreads();
    const XcdBarrier bar = xcd_barrier_post((unsigned*)(args.ws + WS_CTL) + CW_BAR, (volatile LAS unsigned*)(F.lds + MISC_OFF) + 8);
    const int lo = args.ph_lo, hi = args.ph_hi;
#define PHG 0
    PH_IF(PH_IN(0)) { phase_prologue(F, args); PH_SYNC(0); }
#undef PHG
    run_layer<0>(F, args, bar, lo, hi);
    run_layer<1>(F, args, bar, lo, hi);
    run_layer<2>(F, args, bar, lo, hi);
    run_layer<3>(F, args, bar, lo, hi);
#define PHG 20
    PH_IF(PH_IN(PH_FINAL)) { WSL;
        phase_entry_plain<1>(F, WSP(const bf16_t, WS_HB), nullptr, POOLP(const bf16_t, PO_YE), WSP(const int, WS_SLOT), inp(args, I_NFINAL), nullptr, args.out); }
#undef PHG
}

extern "C" void kernel_launch(void* const* d_in, const int* in_sizes, int n_in, void* d_out, int out_size, void* d_ws, size_t ws_size, hipStream_t stream) {
    static int grid = 0;
    if (grid == 0) {
        if (n_in != 33 || in_sizes[0] != T * D || out_size != T * D || ws_size < WS_END) { fprintf(stderr, "kernel_launch: unexpected problem (n_in %d, in0 %d, out %d, ws %zu < %zu)\n", n_in, n_in > 0 ? in_sizes[0] : -1, out_size, ws_size, (size_t)WS_END); grid = -1; return; }
        int dev = 0, cus = 0, per_cu = 0;
        if (hipGetDevice(&dev) != hipSuccess || hipDeviceGetAttribute(&cus, hipDeviceAttributeMultiprocessorCount, dev) != hipSuccess) { grid = -1; return; }
        if (hipFuncSetAttribute((const void*)fwd_kernel, hipFuncAttributeMaxDynamicSharedMemorySize, LDS_BYTES) != hipSuccess) { fprintf(stderr, "kernel_launch: hipFuncSetAttribute failed\n"); grid = -1; return; }
        if (hipOccupancyMaxActiveBlocksPerMultiprocessor(&per_cu, (const void*)fwd_kernel, NTHREADS, LDS_BYTES) != hipSuccess || per_cu < 1) { fprintf(stderr, "kernel_launch: occupancy query says %d\n", per_cu); }
        (void)hipGetLastError();
        grid = cus;
    }
    if (grid < 0) return;
    (void)hipMemsetAsync((char*)d_ws + WS_CTL, 0, CTL_ZERO_BYTES, stream);
    Args a{};
    for (int i = 0; i < 33; ++i) a.in[i] = (const float*)d_in[i];
    a.in[33] = (const float*)d_ws; a.out = (float*)d_out; a.ws = (unsigned char*)d_ws; a.ph_lo = 0; a.ph_hi = PH_COUNT;
    hipLaunchKernelGGL(fwd_kernel, dim3(grid), dim3(NTHREADS), LDS_BYTES, stream, a);
#ifdef TIME_PHASES
#ifndef TIME_DBG
#define TIME_DBG 0
#endif
    { const int ids[] = {TIME_PHASES};
      for (int k = 0; k < (int)(sizeof(ids) / sizeof(ids[0])); ++k) { (void)hipMemsetAsync((char*)d_ws + WS_CTL, 0, 64 * 1024, stream); a.ph_lo = ids[k]; a.ph_hi = ids[k] + 1; a.dbg = TIME_DBG;
        hipLaunchKernelGGL(fwd_kernel, dim3(grid), dim3(NTHREADS), LDS_BYTES, stream, a); } }
#endif
}
```
